# Optimizing an MI355X kernel written in HIP

```python
import jax, jax.numpy as jnp
from jax import lax
import numpy as np

D_MODEL = 1024
BATCH = 4
SEQ = 4096
DEPTH = 2

HEAD_DIM = 64
ROPE_THETA = 10000.0
LN_EPS = 1e-5
A_HEADS = 8
MOBA_BLOCK = 256
MOBA_TOPK = 3
MOBA_Q_CHUNK = 32
B_HEADS = 8
B_KV_HEADS = 2
SWA_WINDOW = 128
C_HEADS = 8
C_NOPE_DIM = 64
C_ROPE_DIM = 32
C_V_DIM = 64
C_KV_LATENT = 128
IDX_HEADS = 8
IDX_DIM = 32
DSA_TOPK = 256
DSA_Q_CHUNK = 128
D_HEADS = 8
SB_Q_BLOCK = 128

MIX_WIDTH = A_HEADS * HEAD_DIM + B_HEADS * HEAD_DIM
EVEN_SIZES = (A_HEADS * HEAD_DIM, A_HEADS * HEAD_DIM, A_HEADS * HEAD_DIM,
              B_HEADS * HEAD_DIM, B_KV_HEADS * HEAD_DIM, B_KV_HEADS * HEAD_DIM, MIX_WIDTH)
ODD_SIZES = (C_HEADS * C_NOPE_DIM, C_HEADS * C_ROPE_DIM, C_KV_LATENT, C_ROPE_DIM,
             IDX_HEADS * IDX_DIM, IDX_DIM, IDX_HEADS,
             D_HEADS * HEAD_DIM, D_HEADS * HEAD_DIM, D_HEADS * HEAD_DIM, MIX_WIDTH)
EVEN_IN = sum(EVEN_SIZES)
ODD_IN = sum(ODD_SIZES)
DEEPNORM_ALPHA = (2 * DEPTH) ** 0.25
DEEPNORM_BETA = (8 * DEPTH) ** -0.25

kernel_name = 'hybrid_moba_swa_dsa_stickbreak_deepnorm'


def _split(x, sizes):
    outs, off = [], 0
    for n in sizes:
        outs.append(x[..., off:off + n])
        off += n
    return outs


def _rope_tables(seq, dim):
    inv = 1.0 / (ROPE_THETA ** (jnp.arange(0, dim, 2, dtype=jnp.float32) / dim))
    ang = jnp.arange(seq, dtype=jnp.float32)[:, None] * inv[None, :]
    return jnp.cos(ang), jnp.sin(ang)


def _apply_rope(x, cos, sin):
    if x.ndim == 4:
        cos, sin = cos[:, None, :], sin[:, None, :]
    cos, sin = cos.astype(x.dtype), sin.astype(x.dtype)
    half = x.shape[-1] // 2
    x1, x2 = x[..., :half], x[..., half:]
    return jnp.concatenate([x1 * cos - x2 * sin, x2 * cos + x1 * sin], axis=-1)


def _layer_norm(x, g, b):
    xf = x.astype(jnp.float32)
    mu = jnp.mean(xf, axis=-1, keepdims=True)
    var = jnp.mean(jnp.square(xf - mu), axis=-1, keepdims=True)
    return ((xf - mu) * lax.rsqrt(var + LN_EPS) * g + b).astype(x.dtype)


def _rms_norm(x, g):
    xf = x.astype(jnp.float32)
    return (xf * lax.rsqrt(jnp.mean(jnp.square(xf), axis=-1, keepdims=True) + LN_EPS) * g).astype(x.dtype)


def _moba_attention(q, k, v):
    bsz, seq, nh, dh = q.shape
    nblk = -(-seq // MOBA_BLOCK)
    pad = nblk * MOBA_BLOCK - seq
    topk = min(MOBA_TOPK, nblk)

    def to_blocks(t):
        t = jnp.pad(t, ((0, 0), (0, pad), (0, 0), (0, 0)))
        return t.reshape(bsz, nblk, MOBA_BLOCK, nh, dh).transpose(0, 3, 1, 2, 4)

    kb, vb = to_blocks(k), to_blocks(v)
    k_mean = jnp.mean(kb.astype(jnp.float32), axis=3).astype(q.dtype)
    n_chunks = seq // MOBA_Q_CHUNK
    qc = q.transpose(0, 2, 1, 3).reshape(bsz, nh, n_chunks, MOBA_Q_CHUNK, dh).transpose(2, 0, 1, 3, 4)
    b_ix = jnp.arange(bsz)[:, None, None, None]
    h_ix = jnp.arange(nh)[None, :, None, None]
    blk_ids = jnp.arange(nblk)
    scale = dh ** -0.5

    def chunk(args):
        qi, ci = args
        t_pos = ci * MOBA_Q_CHUNK + jnp.arange(MOBA_Q_CHUNK)
        own = (ci * MOBA_Q_CHUNK) // MOBA_BLOCK
        gate = jnp.einsum('bhqd,bhnd->bhqn', qi, k_mean).astype(jnp.float32)
        gate = jnp.where(blk_ids < own, gate, -jnp.inf)
        _, sel = lax.top_k(gate, topk)
        sel_ok = sel < own
        k_sel = kb[b_ix, h_ix, sel]
        v_sel = vb[b_ix, h_ix, sel]
        s_sel = jnp.einsum('bhqd,bhqnkd->bhqnk', qi, k_sel).astype(jnp.float32) * scale
        s_sel = jnp.where(sel_ok[..., None], s_sel, -jnp.inf).reshape(bsz, nh, MOBA_Q_CHUNK, topk * MOBA_BLOCK)
        k_own = lax.dynamic_index_in_dim(kb, own, axis=2, keepdims=False)
        v_own = lax.dynamic_index_in_dim(vb, own, axis=2, keepdims=False)
        s_own = jnp.einsum('bhqd,bhkd->bhqk', qi, k_own).astype(jnp.float32) * scale
        k_pos = own * MOBA_BLOCK + jnp.arange(MOBA_BLOCK)
        s_own = jnp.where(k_pos[None, :] <= t_pos[:, None], s_own, -jnp.inf)
        p = jax.nn.softmax(jnp.concatenate([s_sel, s_own], axis=-1), axis=-1).astype(v.dtype)
        p_sel = p[..., :topk * MOBA_BLOCK].reshape(bsz, nh, MOBA_Q_CHUNK, topk, MOBA_BLOCK)
        p_own = p[..., topk * MOBA_BLOCK:]
        return (jnp.einsum('bhqnk,bhqnkd->bhqd', p_sel, v_sel)
                + jnp.einsum('bhqk,bhkd->bhqd', p_own, v_own))

    out = lax.map(chunk, (qc, jnp.arange(n_chunks)))
    return out.transpose(1, 0, 3, 2, 4).reshape(bsz, seq, nh, dh)


def _swa_sink_attention(q, k, v, sinks):
    bsz, seq, nq, dh = q.shape
    nkv = k.shape[2]
    grp = nq // nkv
    w = SWA_WINDOW
    nb = seq // w
    qb = q.reshape(bsz, nb, w, nkv, grp, dh)

    def band(t):
        tb = t.reshape(bsz, nb, w, nkv, dh)
        prev = jnp.pad(tb, ((0, 0), (1, 0), (0, 0), (0, 0), (0, 0)))[:, :-1]
        return jnp.concatenate([prev, tb], axis=2)

    kband, vband = band(k), band(v)
    s = jnp.einsum('bnqkgd,bnskd->bnkgqs', qb, kband).astype(jnp.float32) * dh ** -0.5
    qi = jnp.arange(w)[:, None]
    sj = jnp.arange(2 * w)[None, :]
    in_win = (sj > qi) & (sj <= qi + w)
    real = (jnp.arange(nb) > 0)[:, None, None] | (sj >= w)[None]
    mask = in_win[None] & real
    s = jnp.where(mask[None, :, None, None], s, -jnp.inf)
    sink = jnp.broadcast_to(sinks.astype(jnp.float32).reshape(nkv, grp)[None, None, :, :, None, None],
                            s.shape[:-1] + (1,))
    p = jax.nn.softmax(jnp.concatenate([s, sink], axis=-1), axis=-1)[..., :2 * w].astype(v.dtype)
    o = jnp.einsum('bnkgqs,bnskd->bnqkgd', p, vband)
    return o.reshape(bsz, seq, nq, dh)


def _dsa_attention(q_nope, q_rope, c_kv, k_rope, iq, ik, iw, w_uk, w_uv):
    bsz, seq, nh, _ = q_nope.shape
    n_sel = min(DSA_TOPK, seq // 4)
    nc = seq // DSA_Q_CHUNK
    q_cat = jnp.concatenate([jnp.einsum('bshd,hcd->bshc', q_nope, w_uk), q_rope], axis=-1)
    kv_cat = jnp.concatenate([c_kv, k_rope], axis=-1)
    scale = (C_NOPE_DIM + C_ROPE_DIM) ** -0.5
    idx_scale = (IDX_DIM * IDX_HEADS) ** -0.5
    s_pos = jnp.arange(seq)
    gather = jax.vmap(lambda kv, i: kv[i])

    def chunks(t):
        return t.reshape((bsz, nc, DSA_Q_CHUNK) + t.shape[2:]).swapaxes(0, 1)

    def chunk(args):
        qc, iqc, iwc, ci = args
        t_pos = ci * DSA_Q_CHUNK + jnp.arange(DSA_Q_CHUNK)
        rel = jax.nn.relu(jnp.einsum('bqhd,bsd->bqhs', iqc, ik))
        score = jnp.einsum('bqh,bqhs->bqs', iwc, rel).astype(jnp.float32) * idx_scale
        score = jnp.where(s_pos[None, None, :] <= t_pos[None, :, None], score, -jnp.inf)
        _, sel = lax.top_k(score, n_sel)
        sel_ok = sel <= t_pos[None, :, None]
        kv_sel = gather(kv_cat, sel)
        logits = jnp.einsum('bqhc,bqkc->bqhk', qc, kv_sel).astype(jnp.float32) * scale
        logits = jnp.where(sel_ok[:, :, None, :], logits, -jnp.inf)
        p = jax.nn.softmax(logits, axis=-1).astype(c_kv.dtype)
        return jnp.einsum('bqhk,bqkc->bqhc', p, kv_sel[..., :C_KV_LATENT])

    o_lat = lax.map(chunk, (chunks(q_cat), chunks(iq), chunks(iw), jnp.arange(nc)))
    o_lat = o_lat.swapaxes(0, 1).reshape(bsz, seq, nh, C_KV_LATENT)
    return jnp.einsum('bshc,hcd->bshd', o_lat, w_uv)


def _stick_breaking_attention(q, k, v):
    bsz, seq, nh, dh = q.shape
    nb = seq // SB_Q_BLOCK
    kh = k.transpose(0, 2, 1, 3)
    vh = v.transpose(0, 2, 1, 3)
    qc = q.transpose(0, 2, 1, 3).reshape(bsz, nh, nb, SB_Q_BLOCK, dh).transpose(2, 0, 1, 3, 4)
    s_pos = jnp.arange(seq)

    def block(args):
        qi, bi = args
        t_pos = bi * SB_Q_BLOCK + jnp.arange(SB_Q_BLOCK)
        past = s_pos[None, :] < t_pos[:, None]
        z = jnp.einsum('bhqd,bhsd->bhqs', qi, kh).astype(jnp.float32) * dh ** -0.5
        log_keep = jnp.where(past, jax.nn.log_sigmoid(-z), 0.0)
        log_after = lax.cumsum(log_keep, axis=3, reverse=True) - log_keep
        a = jnp.where(past, jnp.exp(jax.nn.log_sigmoid(z) + log_after), 0.0)
        return jnp.einsum('bhqs,bhsd->bhqd', a.astype(v.dtype), vh)

    out = lax.map(block, (qc, jnp.arange(nb)))
    return out.transpose(1, 0, 3, 2, 4).reshape(bsz, seq, nh, dh)


def _even_mixer(h, w_in, sinks, w_out, rope_h):
    bsz, seq, _ = h.shape
    cos_h, sin_h = rope_h
    aq, ak, av, bq, bk, bv, gate = _split(h @ w_in, EVEN_SIZES)
    aq = _apply_rope(aq.reshape(bsz, seq, A_HEADS, HEAD_DIM), cos_h, sin_h)
    ak = _apply_rope(ak.reshape(bsz, seq, A_HEADS, HEAD_DIM), cos_h, sin_h)
    av = av.reshape(bsz, seq, A_HEADS, HEAD_DIM)
    bq = _apply_rope(bq.reshape(bsz, seq, B_HEADS, HEAD_DIM), cos_h, sin_h)
    bk = _apply_rope(bk.reshape(bsz, seq, B_KV_HEADS, HEAD_DIM), cos_h, sin_h)
    bv = bv.reshape(bsz, seq, B_KV_HEADS, HEAD_DIM)
    oa = _moba_attention(aq, ak, av).reshape(bsz, seq, -1)
    ob = _swa_sink_attention(bq, bk, bv, sinks).reshape(bsz, seq, -1)
    o = jnp.concatenate([oa, ob], axis=-1) * jax.nn.silu(gate)
    return o @ w_out


def _odd_mixer(h, w_in, kv_norm_g, w_uk, w_uv, w_out, rope_r, rope_i):
    bsz, seq, _ = h.shape
    cos_r, sin_r = rope_r
    cos_i, sin_i = rope_i
    cqn, cqr, ckv, ckr, iq, ik, iw, dq, dk, dv, gate = _split(h @ w_in, ODD_SIZES)
    cqn = cqn.reshape(bsz, seq, C_HEADS, C_NOPE_DIM)
    cqr = _apply_rope(cqr.reshape(bsz, seq, C_HEADS, C_ROPE_DIM), cos_r, sin_r)
    ckv = _rms_norm(ckv, kv_norm_g)
    ckr = _apply_rope(ckr, cos_r, sin_r)
    iq = _apply_rope(iq.reshape(bsz, seq, IDX_HEADS, IDX_DIM), cos_i, sin_i)
    ik = _apply_rope(ik, cos_i, sin_i)
    oc = _dsa_attention(cqn, cqr, ckv, ckr, iq, ik, iw, w_uk, w_uv).reshape(bsz, seq, -1)
    od = _stick_breaking_attention(dq.reshape(bsz, seq, D_HEADS, HEAD_DIM),
                                   dk.reshape(bsz, seq, D_HEADS, HEAD_DIM),
                                   dv.reshape(bsz, seq, D_HEADS, HEAD_DIM)).reshape(bsz, seq, -1)
    o = jnp.concatenate([oc, od], axis=-1) * jax.nn.silu(gate)
    return o @ w_out


def setup_inputs(seed: int = 0) -> dict:
    key = jax.random.key(seed)
    ks = jax.random.split(key, 13)
    n_even = (DEPTH + 1) // 2
    n_odd = DEPTH // 2

    def nrm(k, shape, s):
        return jax.random.normal(k, shape, jnp.float32) * s

    return {
        'x': nrm(ks[0], (BATCH, SEQ, D_MODEL), 1.0),
        'c': nrm(ks[1], (BATCH, D_MODEL), 1.0),
        'w_ada': nrm(ks[2], (DEPTH, D_MODEL, 3 * D_MODEL), 0.1 * D_MODEL ** -0.5),
        'b_ada': nrm(ks[3], (DEPTH, 3 * D_MODEL), 0.01),
        'w_in_even': nrm(ks[4], (n_even, D_MODEL, EVEN_IN), D_MODEL ** -0.5),
        'sink_logits': nrm(ks[5], (n_even, B_HEADS), 1.0),
        'w_in_odd': nrm(ks[6], (n_odd, D_MODEL, ODD_IN), D_MODEL ** -0.5),
        'kv_norm_g': 1.0 + nrm(ks[7], (n_odd, C_KV_LATENT), 0.02),
        'w_uk': nrm(ks[8], (n_odd, C_HEADS, C_KV_LATENT, C_NOPE_DIM), C_KV_LATENT ** -0.5),
        'w_uv': nrm(ks[9], (n_odd, C_HEADS, C_KV_LATENT, C_V_DIM), C_KV_LATENT ** -0.5),
        'w_out': nrm(ks[10], (DEPTH, MIX_WIDTH, D_MODEL), MIX_WIDTH ** -0.5 * DEEPNORM_BETA),
        'ln_g': 1.0 + nrm(ks[11], (DEPTH, D_MODEL), 0.02),
        'ln_b': nrm(ks[12], (DEPTH, D_MODEL), 0.02),
    }


def reference(x, c, w_ada, b_ada, w_in_even, sink_logits, w_in_odd, kv_norm_g, w_uk, w_uv, w_out, ln_g, ln_b):
    seq = x.shape[1]
    rope_h = _rope_tables(seq, HEAD_DIM)
    rope_r = _rope_tables(seq, C_ROPE_DIM)
    rope_i = _rope_tables(seq, IDX_DIM)
    cond = jax.nn.silu(c)
    for layer in range(DEPTH):
        shift, scale, gate = jnp.split(cond @ w_ada[layer] + b_ada[layer], 3, axis=-1)
        h = x * (1.0 + scale[:, None, :]) + shift[:, None, :]
        if layer % 2 == 0:
            y = _even_mixer(h, w_in_even[layer // 2], sink_logits[layer // 2], w_out[layer], rope_h)
        else:
            j = layer // 2
            y = _odd_mixer(h, w_in_odd[j], kv_norm_g[j], w_uk[j], w_uv[j], w_out[layer], rope_r, rope_i)
        x = _layer_norm(DEEPNORM_ALPHA * x + (1.0 + gate[:, None, :]) * y, ln_g[layer], ln_b[layer])
    return x
```

```cpp
#include <hip/hip_runtime.h>
#include <hip/hip_cooperative_groups.h>
#include <cstdio>
namespace cg = cooperative_groups;

typedef unsigned short u16;
typedef unsigned long long u64;
typedef __attribute__((ext_vector_type(8))) short bf16x8;
typedef __attribute__((ext_vector_type(4))) float f32x4;

#define DBL 0
#define DEV __device__ __forceinline__
#define NEG_INF (-__builtin_inff())

static constexpr int SEQ = 4096;
static constexpr int NTOK = 16384;
static constexpr int DM = 1024;
static constexpr int EVEN_IN = 3328;
static constexpr int ODD_IN = 3784;
static constexpr int ODD_N = 4352;
static constexpr float LOG2E = 1.4426950408889634f;
static constexpr float LN_EPS = 1e-5f;
static constexpr float DN_ALPHA = 1.4142135623730951f;

struct Params {
  const float *x, *c, *w_ada, *b_ada, *w_in_even, *sinks, *w_in_odd, *kvg, *w_uk, *w_uv, *w_out, *ln_g, *ln_b;
  float* out;
  char* ws;
};
#define P_WTe (reinterpret_cast<u16*>(p.ws + 0ull))
#define P_WTo (reinterpret_cast<u16*>(p.ws + 6815744ull))
#define P_WOT (reinterpret_cast<u16*>(p.ws + 15728640ull))
#define P_WUVp (reinterpret_cast<u16*>(p.ws + 19922944ull))
#define P_mods (reinterpret_cast<float*>(p.ws + 20054016ull))
#define P_cos64 (reinterpret_cast<float*>(p.ws + 20152320ull))
#define P_sin64 (reinterpret_cast<float*>(p.ws + 20676608ull))
#define P_cos32 (reinterpret_cast<float*>(p.ws + 21200896ull))
#define P_sin32 (reinterpret_cast<float*>(p.ws + 21463040ull))
#define P_kpart (reinterpret_cast<float*>(p.ws + 21725184ull))
#define P_stats0 (reinterpret_cast<float*>(p.ws + 22249472ull))
#define P_stats1 (reinterpret_cast<float*>(p.ws + 23298048ull))
#define P_IW (reinterpret_cast<float*>(p.ws + 24346624ull))
#define P_ctr (reinterpret_cast<int*>(p.ws + 24870912ull))
#define P_bar (reinterpret_cast<unsigned*>(p.ws + 24871168ull))
#define P_SG (reinterpret_cast<u16*>(p.ws + 24884992ull))
#define P_OG (reinterpret_cast<u16*>(p.ws + 58439424ull))
#define P_AQ (reinterpret_cast<u16*>(p.ws + 91993856ull))
#define P_AK (reinterpret_cast<u16*>(p.ws + 108771072ull))
#define P_AVt (reinterpret_cast<u16*>(p.ws + 125548288ull))
#define P_BQ (reinterpret_cast<u16*>(p.ws + 142325504ull))
#define P_BKk (reinterpret_cast<u16*>(p.ws + 159102720ull))
#define P_BVt (reinterpret_cast<u16*>(p.ws + 163297024ull))
#define P_QC (reinterpret_cast<u16*>(p.ws + 91993856ull))
#define P_KVC (reinterpret_cast<u16*>(p.ws + 133936896ull))
#define P_CKVt (reinterpret_cast<u16*>(p.ws + 139179776ull))
#define P_IQ (reinterpret_cast<u16*>(p.ws + 143374080ull))
#define P_IK (reinterpret_cast<u16*>(p.ws + 151762688ull))
#define P_DQ (reinterpret_cast<u16*>(p.ws + 152811264ull))
#define P_DK (reinterpret_cast<u16*>(p.ws + 169588480ull))
#define P_DVt (reinterpret_cast<u16*>(p.ws + 186365696ull))
#define P_OLAT (reinterpret_cast<u16*>(p.ws + 203142912ull))
#define P_H (reinterpret_cast<u16*>(p.ws + 203142912ull))
static constexpr size_t WS_NEEDED = 236697344ull;

DEV int opq(int x) { asm volatile("" : "+v"(x)); return x; }
DEV u16 f2bf(float f) { unsigned u = __float_as_uint(f); u += 0x7FFFu + ((u >> 16) & 1u); return (u16)(u >> 16); }
DEV float bf2f(u16 h) { return __uint_as_float(((unsigned)h) << 16); }
DEV unsigned pack2(float a, float b) { unsigned r; asm("v_cvt_pk_bf16_f32 %0, %1, %2" : "=v"(r) : "v"(a), "v"(b)); return r; }
DEV bf16x8 pack8(float a0, float a1, float a2, float a3, float a4, float a5, float a6, float a7) {
  union { bf16x8 v; unsigned u[4]; } r;
  r.u[0] = pack2(a0, a1); r.u[1] = pack2(a2, a3); r.u[2] = pack2(a4, a5); r.u[3] = pack2(a6, a7);
  return r.v;
}
DEV bf16x8 ld8(const u16* p) { return *reinterpret_cast<const bf16x8*>(p); }
DEV f32x4 mfma16(bf16x8 a, bf16x8 b, f32x4 c) { return __builtin_amdgcn_mfma_f32_16x16x32_bf16(a, b, c, 0, 0, 0); }
DEV float fexp2(float x) { return __builtin_amdgcn_exp2f(x); }
DEV float fexp(float x) { return __builtin_amdgcn_exp2f(x * LOG2E); }
DEV float flog(float x) { return __builtin_amdgcn_logf(x) * 0.6931471805599453f; }
DEV float silu_f(float x) { return x / (1.f + fexp(-x)); }
DEV void st8b(u16* p, float a, float b, float c, float d) { uint2 v; v.x = pack2(a, b); v.y = pack2(c, d); *reinterpret_cast<uint2*>(p) = v; }
DEV void st16b(u16* p, const float* v) { uint4 u; u.x = pack2(v[0], v[1]); u.y = pack2(v[2], v[3]); u.z = pack2(v[4], v[5]); u.w = pack2(v[6], v[7]); *reinterpret_cast<uint4*>(p) = u; }


#define XB_TMO      128
#define XB_XCNT(j)  (256  + 64 * (j))
#define XB_XSUB(j)  (1280 + 64 * (j))
#define XB_XGEN(j)  (2304 + 64 * (j))
#define XB_TOP      3328
#define XB_TOPGEN   3392
#define XCD_BAR_WORDS 3456
#define XB_SPIN_CAP (1u << 18)
#define LAS __attribute__((address_space(3)))
DEV unsigned xb_ld(unsigned* p)              { return __hip_atomic_load(p, __ATOMIC_RELAXED, __HIP_MEMORY_SCOPE_AGENT); }
DEV unsigned xb_add(unsigned* p, unsigned v) { return __hip_atomic_fetch_add(p, v, __ATOMIC_RELAXED, __HIP_MEMORY_SCOPE_AGENT); }
DEV unsigned xb_xcc_id() { return (unsigned)__builtin_amdgcn_s_getreg((3 << 11) | 20) & 0xFu; }
#define XB_SPIN(cond, bar) do { unsigned _sp = 0; while (cond) { __builtin_amdgcn_s_sleep(1); \
    if ((++_sp & 255u) == 0u) { if (xb_ld(&(bar)[XB_TMO])) break; if (_sp > XB_SPIN_CAP) { atomicAdd(&(bar)[XB_TMO], 1u); break; } } } } while (0)
struct XcdBarrier { unsigned* bar; unsigned x; volatile LAS unsigned* st; };
DEV XcdBarrier xcd_barrier_post(unsigned* bar, volatile LAS unsigned* st) {
  XcdBarrier b; b.bar = bar; b.x = xb_xcc_id(); b.st = st;
  if (threadIdx.x == 0) st[2] = xb_add(&bar[XB_XCNT(b.x)], 1u);
  return b;
}
DEV void xcd_barrier_complete(unsigned* bar, unsigned x, unsigned& nloc, unsigned& nx, unsigned& before) {
  const unsigned G = gridDim.x * gridDim.y * gridDim.z;
  unsigned sum, cnt, mine, bef, sp = 0u;
  for (;;) {
    sum = 0u; cnt = 0u; mine = 0u; bef = 0u;
#pragma unroll
    for (unsigned j = 0; j < 16; ++j) { const unsigned c = xb_ld(&bar[XB_XCNT(j)]); sum += c; cnt += (c > 0u) ? 1u : 0u; mine = (j == x) ? c : mine; bef += (j < x) ? c : 0u; }
    if (sum == G) break;
    __builtin_amdgcn_s_sleep(1);
    if ((++sp & 255u) == 0u) { if (xb_ld(&bar[XB_TMO])) break; if (sp > XB_SPIN_CAP) { atomicAdd(&bar[XB_TMO], 1u); break; } }
  }
  nloc = mine > 0u ? mine : 1u; nx = cnt > 0u ? cnt : 1u; before = bef;
}
DEV void xcd_barrier(const XcdBarrier& b) {
  asm volatile("s_waitcnt vmcnt(0)" ::: "memory");
  __syncthreads();
  if (threadIdx.x == 0) {
    unsigned* bar = b.bar;
    __builtin_amdgcn_s_waitcnt(0);
    unsigned nloc = b.st[0], nx = b.st[1];
    if (nloc == 0u) { unsigned bef; xcd_barrier_complete(bar, b.x, nloc, nx, bef); b.st[0] = nloc; b.st[1] = nx; b.st[3] = bef + b.st[2]; }
    const unsigned old = xb_add(&bar[XB_XSUB(b.x)], 1u);
    const unsigned gen = old / nloc;
    if (old + 1u == (gen + 1u) * nloc) {
      __builtin_amdgcn_fence(__ATOMIC_RELEASE, "agent");
      asm volatile("s_waitcnt vmcnt(0)" ::: "memory");
      const unsigned og = xb_add(&bar[XB_TOP], 1u);
      const unsigned tg = og / nx;
      if (og + 1u == (tg + 1u) * nx) xb_add(&bar[XB_TOPGEN], 1u);
      else XB_SPIN(xb_ld(&bar[XB_TOPGEN]) == tg, bar);
      __builtin_amdgcn_fence(__ATOMIC_ACQUIRE, "agent");
      xb_add(&bar[XB_XGEN(b.x)], 1u);
      asm volatile("s_waitcnt vmcnt(0)" ::: "memory");
    } else {
      XB_SPIN(xb_ld(&bar[XB_XGEN(b.x)]) == gen, bar);
      __builtin_amdgcn_fence(__ATOMIC_ACQUIRE, "agent");
      asm volatile("s_waitcnt vmcnt(0)" ::: "memory");
    }
  }
  __syncthreads();
}

DEV int odd_srccol(int n) {
  if (n < 1024) return -1;
  if (n < 1280) return 512 + (n - 1024);
  if (n < 1408) return 768 + (n - 1280);
  if (n < 1536) { int j = n - 1408; if (j < 32) return 896 + j; if (j < 64) return 1184 + (j - 32); if (j < 72) return 1216 + (j - 64); return -1; }
  if (n < 1792) return 928 + (n - 1536);
  if (n < 3328) return 1224 + (n - 1792);
  return 2760 + (n - 3328);
}

DEV void p0_transpose(const float* __restrict__ src, int ld, int mapmode, u16* __restrict__ dst, int n0, int k0, float* tile, int tid) {
  const int n = tid & 63;
  const int dn = n0 + n;
  const int sc = mapmode ? odd_srccol(dn) : dn;
#pragma unroll
  for (int i = 0; i < 16; ++i) {
    int kr = (tid >> 6) + 4 * i;
    tile[kr * 65 + n] = (sc >= 0) ? src[(size_t)(k0 + kr) * ld + sc] : 0.f;
  }
  __syncthreads();
#pragma unroll
  for (int i = 0; i < 16; ++i) {
    int nr = (tid >> 6) + 4 * i;
    int k = tid & 63;
    dst[(size_t)(n0 + nr) * 1024 + k0 + k] = f2bf(tile[k * 65 + nr]);
  }
  __syncthreads();
}

DEV void phase0(const Params& p, char* smem, int tid_in) {
  float* fs = reinterpret_cast<float*>(smem);
  const int NITEM = 96 + 512 + 2176 + 64;
  for (int it = blockIdx.x; it < NITEM; it += gridDim.x) {
    const int tid = opq(tid_in);
    if (it < 96) {
      const int col0 = it * 64; const int l = col0 / 3072; const int n0 = col0 % 3072;
      float* sc = fs;
      float* red = fs + 4096;
      for (int e = tid; e < 4096; e += 256) sc[e] = silu_f(p.c[e]);
      __syncthreads();
      const int cgp = tid & 15, ks = tid >> 4;
      float acc[4][4];
#pragma unroll
      for (int b = 0; b < 4; ++b) for (int e = 0; e < 4; ++e) acc[b][e] = 0.f;
      const float* wp = p.w_ada + ((size_t)l * 1024 + ks * 64) * 3072 + n0 + cgp * 4;
#pragma unroll 8
      for (int k = 0; k < 64; ++k) {
        float4 w = *reinterpret_cast<const float4*>(wp + (size_t)k * 3072);
#pragma unroll
        for (int b = 0; b < 4; ++b) {
          float s = sc[b * 1024 + ks * 64 + k];
          acc[b][0] += s * w.x; acc[b][1] += s * w.y; acc[b][2] += s * w.z; acc[b][3] += s * w.w;
        }
      }
#pragma unroll
      for (int b = 0; b < 4; ++b) for (int e = 0; e < 4; ++e) red[(ks * 4 + b) * 64 + cgp * 4 + e] = acc[b][e];
      __syncthreads();
      {
        const int b = tid >> 6, n = tid & 63;
        float s = 0.f;
#pragma unroll
        for (int k2 = 0; k2 < 16; ++k2) s += red[(k2 * 4 + b) * 64 + n];
        P_mods[(size_t)(l * 4 + b) * 3072 + n0 + n] = s + p.b_ada[l * 3072 + n0 + n];
      }
      __syncthreads();
    } else if (it < 608) {
      const int i = it - 96; const int h = i >> 6; const int k0 = ((i >> 2) & 15) * 64; const int cq = i & 3;
      float* Wk = fs;
#pragma unroll
      for (int r = 0; r < 16; ++r) {
        int kk = (tid >> 6) + 4 * r; int d = tid & 63;
        Wk[kk * 65 + d] = p.w_in_odd[(size_t)(k0 + kk) * ODD_IN + h * 64 + d];
      }
      __syncthreads();
      const int kk = tid & 63; const int cgp = tid >> 6;
      float wk[64];
#pragma unroll
      for (int d = 0; d < 64; ++d) wk[d] = Wk[kk * 65 + d];
#pragma unroll 2
      for (int cc = 0; cc < 8; ++cc) {
        const int cidx = cq * 32 + cgp * 8 + cc;
        const float* uk = p.w_uk + ((size_t)(h * 128 + cidx)) * 64;
        float a = 0.f;
#pragma unroll
        for (int d = 0; d < 64; ++d) a += wk[d] * uk[d];
        P_WTo[(size_t)(h * 128 + cidx) * 1024 + k0 + kk] = f2bf(a);
      }
      __syncthreads();
    } else if (it < 608 + 2176) {
      const int i = it - 608;
      if (i < 832) { p0_transpose(p.w_in_even, EVEN_IN, 0, P_WTe, (i >> 4) * 64, (i & 15) * 64, fs, tid); }
      else if (i < 1664) { int j = i - 832; p0_transpose(p.w_in_odd, ODD_IN, 1, P_WTo, 1024 + (j >> 4) * 64, (j & 15) * 64, fs, tid); }
      else { int j = i - 1664; int l = j >> 8; int jj = j & 255; p0_transpose(p.w_out + (size_t)l * 1024 * 1024, 1024, 0, P_WOT + (size_t)l * 1024 * 1024, (jj >> 4) * 64, (jj & 15) * 64, fs, tid); }
    } else {
      const int i = it - 2784;
      const int gtid = i * 256 + tid; const int gstr = 64 * 256;
      if (gtid == 0) { P_ctr[0] = 0; P_ctr[1] = 0; P_ctr[2] = 0; P_ctr[3] = 0; }
      for (int e = gtid; e < 4096 * 32; e += gstr) {
        int pos = e >> 5, f = e & 31;
        float inv = 1.0f / powf(10000.f, (float)(2 * f) / 64.f);
        float ang = (float)pos * inv;
        double rev = (double)ang * 0.15915494309189535; rev -= floor(rev);
        float fr = (float)rev;
        P_cos64[e] = __builtin_amdgcn_cosf(fr); P_sin64[e] = __builtin_amdgcn_sinf(fr);
      }
      for (int e = gtid; e < 4096 * 16; e += gstr) {
        int pos = e >> 4, f = e & 15;
        float inv = 1.0f / powf(10000.f, (float)(2 * f) / 32.f);
        float ang = (float)pos * inv;
        double rev = (double)ang * 0.15915494309189535; rev -= floor(rev);
        float fr = (float)rev;
        P_cos32[e] = __builtin_amdgcn_cosf(fr); P_sin32[e] = __builtin_amdgcn_sinf(fr);
      }
      for (int e = gtid; e < 8 * 128 * 64; e += gstr) {
        int cidx = e & 127, dv = (e >> 7) & 63, h = e >> 13;
        P_WUVp[e] = f2bf(p.w_uv[((size_t)(h * 128 + cidx)) * 64 + dv]);
      }
    }
  }
}

static constexpr int LDA_S = 72;
static constexpr int CS_LD = 132;
static constexpr int ROWSTAT_OFF = 67584;

DEV void row_stats_from_partials(const float* __restrict__ stats, int row, float& mu, float& rstd) {
  const float4* sp = reinterpret_cast<const float4*>(stats + (size_t)row * 16);
  float s = 0.f, ss = 0.f;
#pragma unroll
  for (int i = 0; i < 4; ++i) { float4 v = sp[i]; s += v.x + v.z; ss += v.y + v.w; }
  mu = s * (1.f / 1024.f);
  float var = ss * (1.f / 1024.f) - mu * mu;
  rstd = rsqrtf(fmaxf(var, 0.f) + LN_EPS);
}

template <bool AF32>
DEV void gemm_mainloop(const void* __restrict__ Aptr, const u16* __restrict__ Bt, int m0, int n0,
                       const float* __restrict__ lng, const float* __restrict__ lnb,
                       const float* __restrict__ msc, const float* __restrict__ msh,
                       const float* __restrict__ stats, char* smem, f32x4 (&acc)[4][4], int tid) {
  float* rowstat = reinterpret_cast<float*>(smem + ROWSTAT_OFF);
  const int wave = tid >> 6, lane = tid & 63, lr = lane & 15, quad = lane >> 4;
  const int wm = wave >> 1, wn = wave & 1;
#pragma unroll
  for (int i = 0; i < 4; ++i)
#pragma unroll
    for (int j = 0; j < 4; ++j) acc[i][j] = f32x4{0.f, 0.f, 0.f, 0.f};

  float rmu0 = 0.f, rmu1 = 0.f, rmu2 = 0.f, rmu3 = 0.f, rmu4 = 0.f, rmu5 = 0.f, rmu6 = 0.f, rmu7 = 0.f;
  float rrs0 = 1.f, rrs1 = 1.f, rrs2 = 1.f, rrs3 = 1.f, rrs4 = 1.f, rrs5 = 1.f, rrs6 = 1.f, rrs7 = 1.f;
  if (AF32) {
    if (tid < 128) {
      float mu = 0.f, rs = 1.f;
      if (stats) row_stats_from_partials(stats, m0 + tid, mu, rs);
      rowstat[tid * 2] = mu; rowstat[tid * 2 + 1] = rs;
    }
    __syncthreads();
#define RS_LD(I) { int r = (tid >> 4) + 16 * I; rmu##I = rowstat[r * 2]; rrs##I = rowstat[r * 2 + 1]; }
    RS_LD(0) RS_LD(1) RS_LD(2) RS_LD(3) RS_LD(4) RS_LD(5) RS_LD(6) RS_LD(7)
#undef RS_LD
  }

  uint4 b0, b1, b2, b3, a0, a1, a2, a3;
  float4 f0, f1, f2, f3, f4, f5, f6, f7;
  const int brow = tid >> 3, bpc = tid & 7;
  const u16* bsrc = Bt + (size_t)(n0 + brow) * 1024 + bpc * 8;
  const u16* asrc16 = reinterpret_cast<const u16*>(Aptr) + (size_t)(m0 + brow) * 1024 + bpc * 8;
  const int acg = tid & 15, arow = tid >> 4;
  const float* asrc32 = reinterpret_cast<const float*>(Aptr) + (size_t)(m0 + arow) * 1024 + acg * 4;
  const int bst = brow * 128 + ((bpc ^ ((brow >> 1) & 7)) << 4);
  const int ast = arow * 128 + ((((acg >> 1) ^ ((arow >> 1) & 7))) << 4) + (acg & 1) * 8;
  const int fsw = (lr >> 1) & 7;
  const int ard = (wm * 64 + lr) * 128, brd = 16384 + (wn * 64 + lr) * 128;
  const int fo0 = ((quad ^ fsw) << 4), fo1 = (((4 + quad) ^ fsw) << 4);

#define GEMM_LOAD_TILE(KT) do { const int k0_ = (KT) * 64; \
    b0 = *reinterpret_cast<const uint4*>(bsrc + k0_); b1 = *reinterpret_cast<const uint4*>(bsrc + k0_ + 32 * 1024); \
    b2 = *reinterpret_cast<const uint4*>(bsrc + k0_ + 64 * 1024); b3 = *reinterpret_cast<const uint4*>(bsrc + k0_ + 96 * 1024); \
    if (AF32) { \
      f0 = *reinterpret_cast<const float4*>(asrc32 + (size_t)(0) * 1024 + k0_);  f1 = *reinterpret_cast<const float4*>(asrc32 + (size_t)(16) * 1024 + k0_); \
      f2 = *reinterpret_cast<const float4*>(asrc32 + (size_t)(32) * 1024 + k0_); f3 = *reinterpret_cast<const float4*>(asrc32 + (size_t)(48) * 1024 + k0_); \
      f4 = *reinterpret_cast<const float4*>(asrc32 + (size_t)(64) * 1024 + k0_); f5 = *reinterpret_cast<const float4*>(asrc32 + (size_t)(80) * 1024 + k0_); \
      f6 = *reinterpret_cast<const float4*>(asrc32 + (size_t)(96) * 1024 + k0_); f7 = *reinterpret_cast<const float4*>(asrc32 + (size_t)(112) * 1024 + k0_); \
    } else { \
      a0 = *reinterpret_cast<const uint4*>(asrc16 + k0_); a1 = *reinterpret_cast<const uint4*>(asrc16 + k0_ + 32 * 1024); \
      a2 = *reinterpret_cast<const uint4*>(asrc16 + k0_ + 64 * 1024); a3 = *reinterpret_cast<const uint4*>(asrc16 + k0_ + 96 * 1024); \
    } } while (0)
#define GEMM_AFF(FV, I) do { \
    float q0_ = ((FV).x - rmu##I) * rrs##I * G.x + Bv.x; float q1_ = ((FV).y - rmu##I) * rrs##I * G.y + Bv.y; \
    float q2_ = ((FV).z - rmu##I) * rrs##I * G.z + Bv.z; float q3_ = ((FV).w - rmu##I) * rrs##I * G.w + Bv.w; \
    uint2 pk_; pk_.x = pack2(q0_, q1_); pk_.y = pack2(q2_, q3_); \
    *reinterpret_cast<uint2*>(sb_ + ast + (I) * 2048) = pk_; } while (0)
#define GEMM_STORE_TILE(KT, STG) do { char* sb_ = smem + (STG) * 32768; \
      *reinterpret_cast<uint4*>(sb_ + 16384 + bst) = b0; *reinterpret_cast<uint4*>(sb_ + 16384 + bst + 4096) = b1; \
      *reinterpret_cast<uint4*>(sb_ + 16384 + bst + 8192) = b2; *reinterpret_cast<uint4*>(sb_ + 16384 + bst + 12288) = b3; \
      if (AF32) { \
        const int k = (KT) * 64 + acg * 4; \
        float4 sc = *reinterpret_cast<const float4*>(msc + k); \
        float4 sh = *reinterpret_cast<const float4*>(msh + k); \
        float4 G, Bv; \
        if (lng) { \
          float4 g = *reinterpret_cast<const float4*>(lng + k); \
          float4 bb = *reinterpret_cast<const float4*>(lnb + k); \
          G.x = g.x * (1.f + sc.x); G.y = g.y * (1.f + sc.y); G.z = g.z * (1.f + sc.z); G.w = g.w * (1.f + sc.w); \
          Bv.x = bb.x * (1.f + sc.x) + sh.x; Bv.y = bb.y * (1.f + sc.y) + sh.y; Bv.z = bb.z * (1.f + sc.z) + sh.z; Bv.w = bb.w * (1.f + sc.w) + sh.w; \
        } else { \
          G.x = 1.f + sc.x; G.y = 1.f + sc.y; G.z = 1.f + sc.z; G.w = 1.f + sc.w; \
          Bv = sh; \
        } \
        GEMM_AFF(f0, 0); GEMM_AFF(f1, 1); GEMM_AFF(f2, 2); GEMM_AFF(f3, 3); \
        GEMM_AFF(f4, 4); GEMM_AFF(f5, 5); GEMM_AFF(f6, 6); GEMM_AFF(f7, 7); \
      } else { \
        *reinterpret_cast<uint4*>(sb_ + bst) = a0; *reinterpret_cast<uint4*>(sb_ + bst + 4096) = a1; \
        *reinterpret_cast<uint4*>(sb_ + bst + 8192) = a2; *reinterpret_cast<uint4*>(sb_ + bst + 12288) = a3; \
      } } while (0)

  GEMM_LOAD_TILE(0);
  GEMM_STORE_TILE(0, 0);
  GEMM_LOAD_TILE(1);
  __syncthreads();
  for (int kt = 0; kt < 16; ++kt) {
    const int cur = kt & 1;
    if (kt + 1 < 16) GEMM_STORE_TILE(kt + 1, cur ^ 1);
    if (kt + 2 < 16) GEMM_LOAD_TILE(kt + 2);
    {
      const char* sb = smem + cur * 32768;
      bf16x8 af0[4], bf0[4], af1[4], bf1[4];
#pragma unroll
      for (int mi = 0; mi < 4; ++mi) af0[mi] = *reinterpret_cast<const bf16x8*>(sb + ard + mi * 2048 + fo0);
#pragma unroll
      for (int ni = 0; ni < 4; ++ni) bf0[ni] = *reinterpret_cast<const bf16x8*>(sb + brd + ni * 2048 + fo0);
#pragma unroll
      for (int mi = 0; mi < 4; ++mi) af1[mi] = *reinterpret_cast<const bf16x8*>(sb + ard + mi * 2048 + fo1);
#pragma unroll
      for (int ni = 0; ni < 4; ++ni) bf1[ni] = *reinterpret_cast<const bf16x8*>(sb + brd + ni * 2048 + fo1);
      __builtin_amdgcn_sched_barrier(0);
#pragma unroll
      for (int mi = 0; mi < 4; ++mi)
#pragma unroll
        for (int ni = 0; ni < 4; ++ni) acc[mi][ni] = mfma16(af0[mi], bf0[ni], acc[mi][ni]);
#pragma unroll
      for (int mi = 0; mi < 4; ++mi)
#pragma unroll
        for (int ni = 0; ni < 4; ++ni) acc[mi][ni] = mfma16(af1[mi], bf1[ni], acc[mi][ni]);
    }
    __syncthreads();
  }
}

DEV void stage_all(f32x4 (&acc)[4][4], float* Cs, int tid) {
  const int wave = tid >> 6, lane = tid & 63, lr = lane & 15, quad = lane >> 4;
  const int wm = wave >> 1, wn = wave & 1;
#pragma unroll
  for (int mi = 0; mi < 4; ++mi)
#pragma unroll
    for (int ni = 0; ni < 4; ++ni)
#pragma unroll
      for (int j = 0; j < 4; ++j) Cs[(wm * 64 + mi * 16 + quad * 4 + j) * CS_LD + wn * 64 + ni * 16 + lr] = acc[mi][ni][j];
}

DEV void ld8f(const float* src, float* v) {
  const float4 a = *reinterpret_cast<const float4*>(src), c = *reinterpret_cast<const float4*>(src + 4);
  v[0] = a.x; v[1] = a.y; v[2] = a.z; v[3] = a.w; v[4] = c.x; v[5] = c.y; v[6] = c.z; v[7] = c.w;
}

DEV void epi_rope64(const Params& p, float* Cs, u16* dst, int H, int h0, float scale, bool do_kpart, int b, int pos0, int tid) {
  const int pc = tid & 15, hh = pc >> 3, j0 = (pc & 7) * 4;
#pragma unroll
  for (int ps = 0; ps < 8; ++ps) {
    const int row = ps * 16 + (tid >> 4);
    const int pos = pos0 + row;
    float* cp = Cs + row * CS_LD + hh * 64 + j0;
    const float4 x1 = *reinterpret_cast<const float4*>(cp), x2 = *reinterpret_cast<const float4*>(cp + 32);
    const float4 c = *reinterpret_cast<const float4*>(P_cos64 + (size_t)pos * 32 + j0);
    const float4 sn = *reinterpret_cast<const float4*>(P_sin64 + (size_t)pos * 32 + j0);
    float4 o1, o2;
    o1.x = (x1.x * c.x - x2.x * sn.x) * scale; o2.x = (x2.x * c.x + x1.x * sn.x) * scale;
    o1.y = (x1.y * c.y - x2.y * sn.y) * scale; o2.y = (x2.y * c.y + x1.y * sn.y) * scale;
    o1.z = (x1.z * c.z - x2.z * sn.z) * scale; o2.z = (x2.z * c.z + x1.z * sn.z) * scale;
    o1.w = (x1.w * c.w - x2.w * sn.w) * scale; o2.w = (x2.w * c.w + x1.w * sn.w) * scale;
    u16* d = dst + ((size_t)((b * H + h0 + hh) * SEQ + pos)) * 64 + j0;
    st8b(d, o1.x, o1.y, o1.z, o1.w); st8b(d + 32, o2.x, o2.y, o2.z, o2.w);
    if (do_kpart) { *reinterpret_cast<float4*>(cp) = o1; *reinterpret_cast<float4*>(cp + 32) = o2; }
  }
  if (do_kpart) {
    __syncthreads();
    const int col = tid & 127, hf = tid >> 7;
    float sm = 0.f;
#pragma unroll 16
    for (int r = 0; r < 64; ++r) sm += Cs[(hf * 64 + r) * CS_LD + col];
    P_kpart[((size_t)((b * 8 + h0 + (col >> 6)) * 64 + (pos0 >> 6) + hf)) * 64 + (col & 63)] = sm;
  }
}

DEV void epi_plain_hm(const float* Cs, u16* dst, int H, int h0, float scale, int b, int pos0, int tid) {
  const int pc = tid & 15, hh = pc >> 3, j0 = (pc & 7) * 8;
#pragma unroll
  for (int ps = 0; ps < 8; ++ps) {
    const int row = ps * 16 + (tid >> 4);
    float v[8]; ld8f(Cs + row * CS_LD + pc * 8, v);
#pragma unroll
    for (int e = 0; e < 8; ++e) v[e] *= scale;
    st16b(dst + ((size_t)((b * H + h0 + hh) * SEQ + pos0 + row)) * 64 + j0, v);
  }
}

DEV void epi_vt(const float* Cs, u16* dst, int H, int h0, int DH, int b, int pos0, int tid) {
  for (int idx = tid; idx < 2048; idx += 256) {
    const int quad = idx & 3, c = (idx >> 2) & 127, g = idx >> 9;
    const int h = h0 + c / DH, d = c % DH;
    float v[8];
#pragma unroll
    for (int e = 0; e < 8; ++e) { int srow = g * 32 + (e >> 2) * 16 + quad * 4 + (e & 3); v[e] = Cs[srow * CS_LD + c]; }
    st16b(dst + (((size_t)((b * H + h) * 128 + (pos0 >> 5) + g)) * DH + d) * 32 + quad * 8, v);
  }
}

DEV void epi_silu(const float* Cs, u16* dst, int col0, int tok0, int tid) {
  const int pc = tid & 15;
#pragma unroll
  for (int ps = 0; ps < 8; ++ps) {
    const int row = ps * 16 + (tid >> 4);
    float v[8]; ld8f(Cs + row * CS_LD + pc * 8, v);
#pragma unroll
    for (int e = 0; e < 8; ++e) v[e] = silu_f(v[e]);
    st16b(dst + (size_t)(tok0 + row) * 1024 + col0 + pc * 8, v);
  }
}

DEV void rope32_piece(const Params& p, const float* Cs, int row, int pos, int ch, int j0, float scale, float4& o1, float4& o2) {
  const float* cp = Cs + row * CS_LD + ch * 32 + j0;
  const float4 x1 = *reinterpret_cast<const float4*>(cp), x2 = *reinterpret_cast<const float4*>(cp + 16);
  const float4 c = *reinterpret_cast<const float4*>(P_cos32 + (size_t)pos * 16 + j0);
  const float4 sn = *reinterpret_cast<const float4*>(P_sin32 + (size_t)pos * 16 + j0);
  o1.x = (x1.x * c.x - x2.x * sn.x) * scale; o2.x = (x2.x * c.x + x1.x * sn.x) * scale;
  o1.y = (x1.y * c.y - x2.y * sn.y) * scale; o2.y = (x2.y * c.y + x1.y * sn.y) * scale;
  o1.z = (x1.z * c.z - x2.z * sn.z) * scale; o2.z = (x2.z * c.z + x1.z * sn.z) * scale;
  o1.w = (x1.w * c.w - x2.w * sn.w) * scale; o2.w = (x2.w * c.w + x1.w * sn.w) * scale;
}

DEV void epilogue_inproj(const Params& p, int layer, int nt, float* Cs, int b, int pos0, int tid) {
  const int tok0 = b * SEQ + pos0;
  const int pc = tid & 15;
  if (layer == 0) {
    if (nt < 4) epi_rope64(p, Cs, P_AQ, 8, 2 * nt, 0.125f * LOG2E, false, b, pos0, tid);
    else if (nt < 8) epi_rope64(p, Cs, P_AK, 8, 2 * (nt - 4), 1.f, true, b, pos0, tid);
    else if (nt < 12) epi_vt(Cs, P_AVt, 8, 2 * (nt - 8), 64, b, pos0, tid);
    else if (nt < 16) epi_rope64(p, Cs, P_BQ, 8, 2 * (nt - 12), 0.125f * LOG2E, false, b, pos0, tid);
    else if (nt == 16) epi_rope64(p, Cs, P_BKk, 2, 0, 1.f, false, b, pos0, tid);
    else if (nt == 17) epi_vt(Cs, P_BVt, 2, 0, 64, b, pos0, tid);
    else epi_silu(Cs, P_SG, (nt - 18) * 128, tok0, tid);
  } else {
    const float qscale = 0.10206207261596575f * LOG2E;
    if (nt < 8) {
#pragma unroll
      for (int ps = 0; ps < 8; ++ps) {
        const int row = ps * 16 + (tid >> 4);
        float v[8]; ld8f(Cs + row * CS_LD + pc * 8, v);
#pragma unroll
        for (int e = 0; e < 8; ++e) v[e] *= qscale;
        st16b(P_QC + ((size_t)(tok0 + row) * 8 + nt) * 160 + pc * 8, v);
      }
    } else if (nt < 10 || nt == 12 || nt == 13) {
      const bool isq = nt < 10;
      const int ch = pc >> 2, j0 = (pc & 3) * 4;
      const int h = 4 * (isq ? (nt - 8) : (nt - 12)) + ch;
#pragma unroll
      for (int ps = 0; ps < 8; ++ps) {
        const int row = ps * 16 + (tid >> 4);
        float4 o1, o2; rope32_piece(p, Cs, row, pos0 + row, ch, j0, isq ? qscale : 1.f, o1, o2);
        u16* d = isq ? (P_QC + ((size_t)(tok0 + row) * 8 + h) * 160 + 128 + j0) : (P_IQ + ((size_t)(tok0 + row) * 8 + h) * 32 + j0);
        st8b(d, o1.x, o1.y, o1.z, o1.w); st8b(d + 16, o2.x, o2.y, o2.z, o2.w);
      }
    } else if (nt == 10) {
      float kg[8];
      ld8f(p.kvg + pc * 8, kg);
#pragma unroll
      for (int ps = 0; ps < 8; ++ps) {
        const int row = ps * 16 + (tid >> 4);
        float v[8]; ld8f(Cs + row * CS_LD + pc * 8, v);
        float ss = 0.f;
#pragma unroll
        for (int e = 0; e < 8; ++e) ss += v[e] * v[e];
        ss += __shfl_xor(ss, 1); ss += __shfl_xor(ss, 2); ss += __shfl_xor(ss, 4); ss += __shfl_xor(ss, 8);
        const float rinv = rsqrtf(ss * (1.f / 128.f) + LN_EPS);
#pragma unroll
        for (int e = 0; e < 8; ++e) { v[e] = v[e] * rinv * kg[e]; Cs[row * CS_LD + pc * 8 + e] = v[e]; }
        st16b(P_KVC + (size_t)(tok0 + row) * 160 + pc * 8, v);
      }
      __syncthreads();
      epi_vt(Cs, P_CKVt, 1, 0, 128, b, pos0, tid);
    } else if (nt == 11) {
      const int ch = pc >> 2, j0 = (pc & 3) * 4;
#pragma unroll
      for (int ps = 0; ps < 8; ++ps) {
        const int row = ps * 16 + (tid >> 4);
        if (ch < 2) {
          float4 o1, o2; rope32_piece(p, Cs, row, pos0 + row, ch, j0, 1.f, o1, o2);
          u16* d = (ch == 0) ? (P_KVC + (size_t)(tok0 + row) * 160 + 128 + j0) : (P_IK + (size_t)(tok0 + row) * 32 + j0);
          st8b(d, o1.x, o1.y, o1.z, o1.w); st8b(d + 16, o2.x, o2.y, o2.z, o2.w);
        } else if (pc == 8 || pc == 9) {
          const float4 w = *reinterpret_cast<const float4*>(Cs + row * CS_LD + 64 + (pc - 8) * 4);
          *reinterpret_cast<float4*>(P_IW + (size_t)(tok0 + row) * 8 + (pc - 8) * 4) = w;
        }
      }
    } else if (nt < 18) epi_plain_hm(Cs, P_DQ, 8, 2 * (nt - 14), 0.125f, b, pos0, tid);
    else if (nt < 22) epi_plain_hm(Cs, P_DK, 8, 2 * (nt - 18), 1.f, b, pos0, tid);
    else if (nt < 26) epi_vt(Cs, P_DVt, 8, 2 * (nt - 22), 64, b, pos0, tid);
    else epi_silu(Cs, P_SG, (nt - 26) * 128, tok0, tid);
  }
}

DEV void phase_inproj(const Params& p, int layer, char* smem, int tid_in, int vid) {
  const int NT = layer == 0 ? 26 : 34;
  const int total = 128 * NT;
  float* Cs = reinterpret_cast<float*>(smem);
  for (int it = vid; it < total; it += gridDim.x) {
    const int tid = opq(tid_in);
    const int panel = it / (8 * NT), rem = it % (8 * NT);
    const int nt = rem >> 3, mt = panel * 8 + (rem & 7);
    const int m0 = mt * 128, n0 = nt * 128;
    const int b = m0 >> 12;
    f32x4 acc[4][4];
    gemm_mainloop<false>(P_H, layer == 0 ? P_WTe : P_WTo, m0, n0, nullptr, nullptr, nullptr, nullptr, nullptr, smem, acc, tid);
    stage_all(acc, Cs, tid);
    __syncthreads();
    epilogue_inproj(p, layer, nt, Cs, b, (m0 & 4095), tid);
    __syncthreads();
  }
}

DEV float half32_sum_at31(float v) {
  float x = v;
  x += __builtin_amdgcn_update_dpp(0.f, x, 0x111, 0xf, 0xf, false);
  x += __builtin_amdgcn_update_dpp(0.f, x, 0x112, 0xf, 0xf, false);
  x += __builtin_amdgcn_update_dpp(0.f, x, 0x114, 0xf, 0xf, false);
  x += __builtin_amdgcn_update_dpp(0.f, x, 0x118, 0xf, 0xf, false);
  const auto r = __builtin_amdgcn_permlane16_swap(__float_as_uint(x), __float_as_uint(x), false, false);
  return __uint_as_float(r[0]) + __uint_as_float(r[1]);
}
DEV void phase_outproj(const Params& p, int layer, char* smem, int tid_in, int vid) {
  float* Cs = reinterpret_cast<float*>(smem);
  float* rowstat = reinterpret_cast<float*>(smem + ROWSTAT_OFF);
  const u16* Bt = P_WOT + (size_t)layer * 1024 * 1024;
  float* stats_out = layer == 0 ? P_stats0 : P_stats1;
  for (int it = vid; it < 128 * 8; it += gridDim.x) {
    const int tid = opq(tid_in);
    const int nt = (it >> 3) & 7, mt = (it >> 6) * 8 + (it & 7);
    const int m0 = mt * 128, n0 = nt * 128;
    const int b = m0 >> 12;
    f32x4 acc[4][4];
    gemm_mainloop<false>(P_OG, Bt, m0, n0, nullptr, nullptr, nullptr, nullptr, nullptr, smem, acc, tid);
    if (layer == 1) {
      if (tid < 128) { float mu, rs; row_stats_from_partials(P_stats0, m0 + tid, mu, rs); rowstat[tid * 2] = mu; rowstat[tid * 2 + 1] = rs; }
    }
    const float* gate = P_mods + (size_t)(layer * 4 + b) * 3072 + 2048;
    stage_all(acc, Cs, tid);
    __syncthreads();
    {
      const int l32 = tid & 31, rgrp = tid >> 5;
      const int gc = n0 + l32 * 4;
      const float4 gt = *reinterpret_cast<const float4*>(gate + gc);
      float4 lg = make_float4(0.f, 0.f, 0.f, 0.f), lb = lg;
      if (layer == 1) { lg = *reinterpret_cast<const float4*>(p.ln_g + gc); lb = *reinterpret_cast<const float4*>(p.ln_b + gc); }
#pragma unroll 4
      for (int ps = 0; ps < 16; ++ps) {
        const int lrow = ps * 8 + rgrp;
        const size_t grow = (size_t)(m0 + lrow);
        float4 xr;
        if (layer == 0) xr = *reinterpret_cast<const float4*>(p.x + grow * 1024 + gc);
        else {
          const float mu = rowstat[lrow * 2], rs = rowstat[lrow * 2 + 1];
          const float4 v0 = *reinterpret_cast<const float4*>(p.out + grow * 1024 + gc);
          xr.x = (v0.x - mu) * rs * lg.x + lb.x; xr.y = (v0.y - mu) * rs * lg.y + lb.y;
          xr.z = (v0.z - mu) * rs * lg.z + lb.z; xr.w = (v0.w - mu) * rs * lg.w + lb.w;
        }
        const float4 y = *reinterpret_cast<const float4*>(Cs + lrow * CS_LD + l32 * 4);
        float4 v;
        v.x = DN_ALPHA * xr.x + (1.f + gt.x) * y.x; v.y = DN_ALPHA * xr.y + (1.f + gt.y) * y.y;
        v.z = DN_ALPHA * xr.z + (1.f + gt.z) * y.z; v.w = DN_ALPHA * xr.w + (1.f + gt.w) * y.w;
        float sm = v.x + v.y + v.z + v.w, ss = v.x * v.x + v.y * v.y + v.z * v.z + v.w * v.w;
        *reinterpret_cast<float4*>(p.out + grow * 1024 + gc) = v;
        sm = half32_sum_at31(sm); ss = half32_sum_at31(ss);
        if (l32 == 31) { stats_out[grow * 16 + nt * 2] = sm; stats_out[grow * 16 + nt * 2 + 1] = ss; }
      }
    }
    __syncthreads();
  }
}

DEV void phase_prep(const Params& p, int layer, int tid) {
  const int lane = tid & 63;
  const int gw = blockIdx.x * 4 + (tid >> 6), nw = gridDim.x * 4;
  for (int row = gw; row < NTOK; row += nw) {
    const int b = row >> 12;
    const float* modb = P_mods + (size_t)(layer * 4 + b) * 3072;
    const float* src = (layer == 0 ? p.x : p.out) + (size_t)row * 1024;
    float mu = 0.f, rs = 1.f;
    if (layer == 1) row_stats_from_partials(P_stats0, row, mu, rs);
    u16* dst = P_H + (size_t)row * 1024;
#pragma unroll
    for (int i = 0; i < 4; ++i) {
      const int c = i * 256 + lane * 4;
      float4 v = *reinterpret_cast<const float4*>(src + c);
      if (layer == 1) {
        const float4 g = *reinterpret_cast<const float4*>(p.ln_g + c);
        const float4 bb = *reinterpret_cast<const float4*>(p.ln_b + c);
        v.x = (v.x - mu) * rs * g.x + bb.x; v.y = (v.y - mu) * rs * g.y + bb.y;
        v.z = (v.z - mu) * rs * g.z + bb.z; v.w = (v.w - mu) * rs * g.w + bb.w;
      }
      const float4 sh = *reinterpret_cast<const float4*>(modb + c);
      const float4 sc = *reinterpret_cast<const float4*>(modb + 1024 + c);
      st8b(dst + c, v.x * (1.f + sc.x) + sh.x, v.y * (1.f + sc.y) + sh.y, v.z * (1.f + sc.z) + sh.z, v.w * (1.f + sc.w) + sh.w);
    }
  }
}

DEV void phase_final_ln(const Params& p, int tid) {
  const int lane = tid & 63;
  const int gw = blockIdx.x * 4 + (tid >> 6), nw = gridDim.x * 4;
  const float* g = p.ln_g + 1024; const float* bb = p.ln_b + 1024;
  for (int row = gw; row < NTOK; row += nw) {
    float mu, rs; row_stats_from_partials(P_stats1, row, mu, rs);
    float* rp = p.out + (size_t)row * 1024;
#pragma unroll
    for (int i = 0; i < 4; ++i) {
      const int c = i * 256 + lane * 4;
      float4 v = *reinterpret_cast<const float4*>(rp + c);
      float4 gg = *reinterpret_cast<const float4*>(g + c);
      float4 b4 = *reinterpret_cast<const float4*>(bb + c);
      v.x = (v.x - mu) * rs * gg.x + b4.x; v.y = (v.y - mu) * rs * gg.y + b4.y;
      v.z = (v.z - mu) * rs * gg.z + b4.z; v.w = (v.w - mu) * rs * gg.w + b4.w;
      *reinterpret_cast<float4*>(rp + c) = v;
    }
  }
}

DEV float xq_max(float x) {
  unsigned u = __float_as_uint(x);
  auto r = __builtin_amdgcn_permlane32_swap(u, u, false, false);
  const float m = fmaxf(__uint_as_float(r[0]), __uint_as_float(r[1]));
  unsigned v = __float_as_uint(m);
  auto s2 = __builtin_amdgcn_permlane16_swap(v, v, false, false);
  return fmaxf(__uint_as_float(s2[0]), __uint_as_float(s2[1]));
}
DEV float xq_sum(float x) {
  unsigned u = __float_as_uint(x);
  auto r = __builtin_amdgcn_permlane32_swap(u, u, false, false);
  const float m = __uint_as_float(r[0]) + __uint_as_float(r[1]);
  unsigned v = __float_as_uint(m);
  auto s2 = __builtin_amdgcn_permlane16_swap(v, v, false, false);
  return __uint_as_float(s2[0]) + __uint_as_float(s2[1]);
}
template <int NKS, int NDT, class MaskF>
DEV void flash_chunk(const u16* __restrict__ Kc, int ldk, const u16* __restrict__ Vc, const bf16x8 (&qf)[2][NKS],
                     float (&m)[2], float (&l)[2], f32x4 (&o)[NDT][2], int lane, MaskF mask) {
  const int lr = lane & 15, quad = lane >> 4;
  f32x4 st[4][2];
#pragma unroll
  for (int kt = 0; kt < 4; ++kt) { st[kt][0] = f32x4{0.f, 0.f, 0.f, 0.f}; st[kt][1] = f32x4{0.f, 0.f, 0.f, 0.f}; }
#pragma unroll
  for (int kt = 0; kt < 4; ++kt)
#pragma unroll
    for (int ks = 0; ks < NKS; ++ks) {
      bf16x8 kf = ld8(Kc + (size_t)(kt * 16 + lr) * ldk + ks * 32 + quad * 8);
      st[kt][0] = mfma16(kf, qf[0][ks], st[kt][0]);
      st[kt][1] = mfma16(kf, qf[1][ks], st[kt][1]);
    }
#pragma unroll
  for (int c = 0; c < 2; ++c) {
    float cm = NEG_INF;
#pragma unroll
    for (int kt = 0; kt < 4; ++kt)
#pragma unroll
      for (int j = 0; j < 4; ++j) { float s = mask(kt, j, c) ? st[kt][c][j] : NEG_INF; st[kt][c][j] = s; cm = fmaxf(cm, s); }
    cm = xq_max(cm);
    const float mn = fmaxf(m[c], cm);
    const float ms = (mn == NEG_INF) ? 0.f : mn;
    const float alpha = fexp2(m[c] - ms);
    m[c] = mn;
    float ps = 0.f;
#pragma unroll
    for (int kt = 0; kt < 4; ++kt)
#pragma unroll
      for (int j = 0; j < 4; ++j) { float pv = fexp2(st[kt][c][j] - ms); st[kt][c][j] = pv; ps += pv; }
    l[c] = l[c] * alpha + ps;
#pragma unroll
    for (int dt = 0; dt < NDT; ++dt) { o[dt][c][0] *= alpha; o[dt][c][1] *= alpha; o[dt][c][2] *= alpha; o[dt][c][3] *= alpha; }
  }
  bf16x8 pb[2][2];
#pragma unroll
  for (int c = 0; c < 2; ++c)
#pragma unroll
    for (int g = 0; g < 2; ++g)
      pb[c][g] = pack8(st[2 * g][c][0], st[2 * g][c][1], st[2 * g][c][2], st[2 * g][c][3],
                       st[2 * g + 1][c][0], st[2 * g + 1][c][1], st[2 * g + 1][c][2], st[2 * g + 1][c][3]);
#pragma unroll
  for (int g = 0; g < 2; ++g)
#pragma unroll
    for (int dt = 0; dt < NDT; ++dt) {
      bf16x8 vf = ld8(Vc + ((size_t)((g * NDT + dt) * 16 + lr) * 4 + quad) * 8);
      o[dt][0] = mfma16(vf, pb[0][g], o[dt][0]);
      o[dt][1] = mfma16(vf, pb[1][g], o[dt][1]);
    }
}

DEV void load_kv64(const u16* __restrict__ Kc, const u16* __restrict__ Vc, bf16x8 (&kf)[4][2], bf16x8 (&vf)[2][4], int lane) {
  const int lr = lane & 15, quad = lane >> 4;
#pragma unroll
  for (int kt = 0; kt < 4; ++kt)
#pragma unroll
    for (int ks = 0; ks < 2; ++ks) kf[kt][ks] = ld8(Kc + (size_t)(kt * 16 + lr) * 64 + ks * 32 + quad * 8);
#pragma unroll
  for (int g = 0; g < 2; ++g)
#pragma unroll
    for (int dt = 0; dt < 4; ++dt) vf[g][dt] = ld8(Vc + ((size_t)((g * 4 + dt) * 16 + lr) * 4 + quad) * 8);
}
DEV void copy_kv64(bf16x8 (&kd)[4][2], bf16x8 (&vd)[2][4], const bf16x8 (&ks_)[4][2], const bf16x8 (&vs)[2][4]) {
#pragma unroll
  for (int a = 0; a < 4; ++a) { kd[a][0] = ks_[a][0]; kd[a][1] = ks_[a][1]; }
#pragma unroll
  for (int g = 0; g < 2; ++g)
#pragma unroll
    for (int dt = 0; dt < 4; ++dt) vd[g][dt] = vs[g][dt];
}
template <class MaskF>
DEV void flash_chunk_pre(const bf16x8 (&kf)[4][2], const bf16x8 (&vf)[2][4], const bf16x8 (&qf)[2][2],
                         float (&m)[2], float (&l)[2], f32x4 (&o)[4][2], int lane, MaskF mask) {
  f32x4 st[4][2];
#pragma unroll
  for (int kt = 0; kt < 4; ++kt) {
    st[kt][0] = f32x4{0.f, 0.f, 0.f, 0.f}; st[kt][1] = f32x4{0.f, 0.f, 0.f, 0.f};
#pragma unroll
    for (int ks = 0; ks < 2; ++ks) { st[kt][0] = mfma16(kf[kt][ks], qf[0][ks], st[kt][0]); st[kt][1] = mfma16(kf[kt][ks], qf[1][ks], st[kt][1]); }
  }
#pragma unroll
  for (int c = 0; c < 2; ++c) {
    float cm = NEG_INF;
#pragma unroll
    for (int kt = 0; kt < 4; ++kt)
#pragma unroll
      for (int j = 0; j < 4; ++j) { float sv = mask(kt, j, c) ? st[kt][c][j] : NEG_INF; st[kt][c][j] = sv; cm = fmaxf(cm, sv); }
    cm = xq_max(cm);
    if (!__all(cm <= m[c] + 8.f)) {
      const float mn = fmaxf(m[c], cm);
      const float msn = (mn == NEG_INF) ? 0.f : mn;
      const float alpha = fexp2(m[c] - msn);
      m[c] = mn;
      l[c] *= alpha;
#pragma unroll
      for (int dt = 0; dt < 4; ++dt) { o[dt][c][0] *= alpha; o[dt][c][1] *= alpha; o[dt][c][2] *= alpha; o[dt][c][3] *= alpha; }
    }
    const float ms = (m[c] == NEG_INF) ? 0.f : m[c];
    float ps = 0.f;
#pragma unroll
    for (int kt = 0; kt < 4; ++kt)
#pragma unroll
      for (int j = 0; j < 4; ++j) { float pv = fexp2(st[kt][c][j] - ms); st[kt][c][j] = pv; ps += pv; }
    l[c] += ps;
  }
#pragma unroll
  for (int g = 0; g < 2; ++g) {
    const bf16x8 p0 = pack8(st[2 * g][0][0], st[2 * g][0][1], st[2 * g][0][2], st[2 * g][0][3], st[2 * g + 1][0][0], st[2 * g + 1][0][1], st[2 * g + 1][0][2], st[2 * g + 1][0][3]);
    const bf16x8 p1 = pack8(st[2 * g][1][0], st[2 * g][1][1], st[2 * g][1][2], st[2 * g][1][3], st[2 * g + 1][1][0], st[2 * g + 1][1][1], st[2 * g + 1][1][2], st[2 * g + 1][1][3]);
#pragma unroll
    for (int dt = 0; dt < 4; ++dt) { o[dt][0] = mfma16(vf[g][dt], p0, o[dt][0]); o[dt][1] = mfma16(vf[g][dt], p1, o[dt][1]); }
  }
}

DEV void write_og4(const Params& p, f32x4 (&o)[4][2], const float (&inv)[2], int b, int tq0, int colbase, int lane) {
  const int lr = lane & 15, quad = lane >> 4;
#pragma unroll
  for (int c = 0; c < 2; ++c) {
    const size_t base = ((size_t)(b * SEQ + tq0 + c * 16 + lr)) * 1024 + colbase + quad * 4;
#pragma unroll
    for (int dt = 0; dt < 4; ++dt) {
      uint2 sg = *reinterpret_cast<const uint2*>(P_SG + base + dt * 16);
      float g0 = bf2f((u16)(sg.x & 0xFFFF)), g1 = bf2f((u16)(sg.x >> 16)), g2 = bf2f((u16)(sg.y & 0xFFFF)), g3 = bf2f((u16)(sg.y >> 16));
      st8b(P_OG + base + dt * 16, o[dt][c][0] * inv[c] * g0, o[dt][c][1] * inv[c] * g1, o[dt][c][2] * inv[c] * g2, o[dt][c][3] * inv[c] * g3);
    }
  }
}

DEV float quad_sum(float v) { return xq_sum(v); }

DEV void moba_item(const Params& p, int b, int h, int qt, int wave, int lane, char* smem) {
  const int lr = lane & 15, quad = lane >> 4;
  const int q0 = qt * 128 + wave * 32;
  const int own = q0 >> 8;
  const size_t hb = (size_t)(b * 8 + h) * SEQ * 64;
  const u16* Q = P_AQ + hb; const u16* K = P_AK + hb; const u16* Vt = P_AVt + hb;
  bf16x8 qf[2][2];
#pragma unroll
  for (int c = 0; c < 2; ++c)
#pragma unroll
    for (int ks = 0; ks < 2; ++ks) qf[c][ks] = ld8(Q + (size_t)(q0 + c * 16 + lr) * 64 + ks * 32 + quad * 8);
  unsigned selmask[2] = {0u, 0u};
  if (own > 0) {
    bf16x8 kmf[2];
#pragma unroll
    for (int ks = 0; ks < 2; ++ks) {
      float s[8];
#pragma unroll
      for (int e = 0; e < 8; ++e) s[e] = 0.f;
      if (lr < own) {
#pragma unroll
        for (int part = 0; part < 4; ++part) {
          const float* kp = P_kpart + ((size_t)((b * 8 + h) * 64 + lr * 4 + part)) * 64 + ks * 32 + quad * 8;
          float4 a = *reinterpret_cast<const float4*>(kp); float4 bq = *reinterpret_cast<const float4*>(kp + 4);
          s[0] += a.x; s[1] += a.y; s[2] += a.z; s[3] += a.w; s[4] += bq.x; s[5] += bq.y; s[6] += bq.z; s[7] += bq.w;
        }
      }
      const float r = 1.f / 256.f;
      kmf[ks] = pack8(s[0] * r, s[1] * r, s[2] * r, s[3] * r, s[4] * r, s[5] * r, s[6] * r, s[7] * r);
    }
#pragma unroll
    for (int c = 0; c < 2; ++c) {
      f32x4 g = f32x4{0.f, 0.f, 0.f, 0.f};
      g = mfma16(kmf[0], qf[c][0], g); g = mfma16(kmf[1], qf[c][1], g);
      float v[4];
#pragma unroll
      for (int j = 0; j < 4; ++j) v[j] = (quad * 4 + j < own) ? g[j] : NEG_INF;
      unsigned sm = 0u;
#pragma unroll
      for (int itr = 0; itr < 3; ++itr) {
        float best = NEG_INF; int bi = 99;
#pragma unroll
        for (int j = 0; j < 4; ++j) if (v[j] > best) { best = v[j]; bi = quad * 4 + j; }
#pragma unroll
        for (int off = 16; off <= 32; off <<= 1) {
          float ob = __shfl_xor(best, off); int oi = __shfl_xor(bi, off);
          if (ob > best || (ob == best && oi < bi)) { best = ob; bi = oi; }
        }
        if (bi < 16) {
          sm |= 1u << bi;
#pragma unroll
          for (int j = 0; j < 4; ++j) if (quad * 4 + j == bi) v[j] = NEG_INF;
        }
      }
      selmask[c] = sm;
    }
  }
  float m[2] = {NEG_INF, NEG_INF}, l[2] = {0.f, 0.f};
  f32x4 o[4][2];
#pragma unroll
  for (int dt = 0; dt < 4; ++dt) { o[dt][0] = f32x4{0.f, 0.f, 0.f, 0.f}; o[dt][1] = f32x4{0.f, 0.f, 0.f, 0.f}; }
  {
    const int tid = wave * 64 + lane;
    const int cend_w = (q0 + 31) >> 6;
    const int cend_b = (qt * 128 + 127) >> 6;
    uint4 r0, r1, r2, r3;
    const int kid0 = tid, kid1 = tid + 256;
    const int krow0 = kid0 >> 3, kc0 = kid0 & 7, krow1 = kid1 >> 3, kc1 = kid1 & 7;
    const int kst0 = krow0 * 128 + ((kc0 ^ ((krow0 >> 1) & 7)) << 4), kst1 = krow1 * 128 + ((kc1 ^ ((krow1 >> 1) & 7)) << 4);
    const int vlr0 = (kid0 >> 2) & 15, vq0 = kid0 & 3, vlr1 = (kid1 >> 2) & 15, vq1 = kid1 & 3;
    const int vst0 = 8192 + (kid0 >> 6) * 1024 + vlr0 * 64 + ((vq0 ^ (vlr0 >= 8 ? 3 : 0)) << 4);
    const int vst1 = 8192 + (kid1 >> 6) * 1024 + vlr1 * 64 + ((vq1 ^ (vlr1 >= 8 ? 3 : 0)) << 4);
#define MOBA_LOAD(CH) do { const u16* kg_ = K + (size_t)(CH) * 64 * 64; const u16* vg_ = Vt + (size_t)(CH) * 2 * 64 * 32; \
      r0 = *reinterpret_cast<const uint4*>(kg_ + kid0 * 8); r1 = *reinterpret_cast<const uint4*>(kg_ + kid1 * 8); \
      r2 = *reinterpret_cast<const uint4*>(vg_ + kid0 * 8); r3 = *reinterpret_cast<const uint4*>(vg_ + kid1 * 8); } while (0)
#define MOBA_STORE(STG) do { char* sb_ = smem + (STG) * 16384; \
      *reinterpret_cast<uint4*>(sb_ + kst0) = r0; *reinterpret_cast<uint4*>(sb_ + kst1) = r1; \
      *reinterpret_cast<uint4*>(sb_ + vst0) = r2; *reinterpret_cast<uint4*>(sb_ + vst1) = r3; } while (0)
    const int kro = lr * 128, ksw = (lr >> 1) & 7;
    const int vro = 8192 + lr * 64 + ((quad ^ (lr >= 8 ? 3 : 0)) << 4);
    MOBA_LOAD(0);
    MOBA_STORE(0);
    if (cend_b >= 1) MOBA_LOAD(1);
    __syncthreads();
    for (int chk = 0; chk <= cend_b; ++chk) {
      if (chk + 1 <= cend_b) MOBA_STORE((chk + 1) & 1);
      if (chk + 2 <= cend_b) MOBA_LOAD(chk + 2);
      const int cb = chk * 64, n = chk >> 2;
      const bool past = n < own;
      const bool s0 = (selmask[0] >> n) & 1u, s1 = (selmask[1] >> n) & 1u;
      if (chk <= cend_w && (!past || __ballot(s0 || s1) != 0ull)) {
        const char* sb = smem + (chk & 1) * 16384;
        bf16x8 kc[4][2], vc[2][4];
#pragma unroll
        for (int kt = 0; kt < 4; ++kt)
#pragma unroll
          for (int ks = 0; ks < 2; ++ks) kc[kt][ks] = *reinterpret_cast<const bf16x8*>(sb + kt * 2048 + kro + (((ks * 4 + quad) ^ ksw) << 4));
#pragma unroll
        for (int g = 0; g < 2; ++g)
#pragma unroll
          for (int dt = 0; dt < 4; ++dt) vc[g][dt] = *reinterpret_cast<const bf16x8*>(sb + (g * 4 + dt) * 1024 + vro);
        flash_chunk_pre(kc, vc, qf, m, l, o, lane,
                        [&](int kt, int j, int c) { return past ? (c ? s1 : s0) : ((cb + kt * 16 + quad * 4 + j) <= (q0 + c * 16 + lr)); });
      }
      __syncthreads();
    }
  }
  float inv[2];
  inv[0] = 1.f / quad_sum(l[0]); inv[1] = 1.f / quad_sum(l[1]);
  write_og4(p, o, inv, b, q0, h * 64, lane);
}

DEV void swa_item(const Params& p, int b, int kvh, int t32, int wave, int lane, char* smem) {
  const int lr = lane & 15, quad = lane >> 4;
  const int q0 = t32 * 32;
  const int qh = kvh * 4 + wave;
  const u16* Q = P_BQ + (size_t)(b * 8 + qh) * SEQ * 64;
  const u16* K = P_BKk + (size_t)(b * 2 + kvh) * SEQ * 64;
  const u16* Vt = P_BVt + (size_t)(b * 2 + kvh) * SEQ * 64;
  bf16x8 qf[2][2];
#pragma unroll
  for (int c = 0; c < 2; ++c)
#pragma unroll
    for (int ks = 0; ks < 2; ++ks) qf[c][ks] = ld8(Q + (size_t)(q0 + c * 16 + lr) * 64 + ks * 32 + quad * 8);
  float m[2] = {NEG_INF, NEG_INF}, l[2] = {0.f, 0.f};
  f32x4 o[4][2];
#pragma unroll
  for (int dt = 0; dt < 4; ++dt) { o[dt][0] = f32x4{0.f, 0.f, 0.f, 0.f}; o[dt][1] = f32x4{0.f, 0.f, 0.f, 0.f}; }
  {
    const int tid = wave * 64 + lane;
    const int lo = (q0 - 127) > 0 ? (q0 - 127) : 0;
    const int c0 = lo >> 6, c1 = (q0 + 31) >> 6;
    uint4 r0, r1, r2, r3;
    const int kid0 = tid, kid1 = tid + 256;
    const int krow0 = kid0 >> 3, kc0 = kid0 & 7, krow1 = kid1 >> 3, kc1 = kid1 & 7;
    const int kst0 = krow0 * 128 + ((kc0 ^ ((krow0 >> 1) & 7)) << 4), kst1 = krow1 * 128 + ((kc1 ^ ((krow1 >> 1) & 7)) << 4);
    const int vlr0 = (kid0 >> 2) & 15, vq0 = kid0 & 3, vlr1 = (kid1 >> 2) & 15, vq1 = kid1 & 3;
    const int vst0 = 8192 + (kid0 >> 6) * 1024 + vlr0 * 64 + ((vq0 ^ (vlr0 >= 8 ? 3 : 0)) << 4);
    const int vst1 = 8192 + (kid1 >> 6) * 1024 + vlr1 * 64 + ((vq1 ^ (vlr1 >= 8 ? 3 : 0)) << 4);
    const int kro = lr * 128, ksw = (lr >> 1) & 7;
    const int vro = 8192 + lr * 64 + ((quad ^ (lr >= 8 ? 3 : 0)) << 4);
    MOBA_LOAD(c0);
    MOBA_STORE(0);
    if (c0 + 1 <= c1) MOBA_LOAD(c0 + 1);
    __syncthreads();
    for (int chk = c0; chk <= c1; ++chk) {
      const int stg = (chk - c0) & 1;
      if (chk + 1 <= c1) MOBA_STORE(stg ^ 1);
      if (chk + 2 <= c1) MOBA_LOAD(chk + 2);
      const int cb = chk * 64;
      {
        const char* sb = smem + stg * 16384;
        bf16x8 kc[4][2], vc[2][4];
#pragma unroll
        for (int kt = 0; kt < 4; ++kt)
#pragma unroll
          for (int ks = 0; ks < 2; ++ks) kc[kt][ks] = *reinterpret_cast<const bf16x8*>(sb + kt * 2048 + kro + (((ks * 4 + quad) ^ ksw) << 4));
#pragma unroll
        for (int g = 0; g < 2; ++g)
#pragma unroll
          for (int dt = 0; dt < 4; ++dt) vc[g][dt] = *reinterpret_cast<const bf16x8*>(sb + (g * 4 + dt) * 1024 + vro);
        flash_chunk_pre(kc, vc, qf, m, l, o, lane,
                        [&](int kt, int j, int c) { int key = cb + kt * 16 + quad * 4 + j; int t = q0 + c * 16 + lr; return key <= t && key > t - 128; });
      }
      __syncthreads();
    }
  }
  const float sl = p.sinks[qh] * LOG2E;
  float inv[2];
#pragma unroll
  for (int c = 0; c < 2; ++c) {
    float lt = quad_sum(l[c]);
    float mf = fmaxf(m[c], sl);
    float a = fexp2(m[c] - mf);
    inv[c] = a / (lt * a + fexp2(sl - mf));
  }
  write_og4(p, o, inv, b, q0, 512 + qh * 64, lane);
}

DEV void sb_item(const Params& p, int b, int h, int qt, int wave, int lane) {
  const int lr = lane & 15, quad = lane >> 4;
  const int q0 = qt * 128 + wave * 32;
  const size_t hb = (size_t)(b * 8 + h) * SEQ * 64;
  const u16* Q = P_DQ + hb; const u16* K = P_DK + hb; const u16* Vt = P_DVt + hb;
  bf16x8 qf[2][2];
#pragma unroll
  for (int c = 0; c < 2; ++c)
#pragma unroll
    for (int ks = 0; ks < 2; ++ks) qf[c][ks] = ld8(Q + (size_t)(q0 + c * 16 + lr) * 64 + ks * 32 + quad * 8);
  float carry[2] = {0.f, 0.f};
  f32x4 o[4][2];
#pragma unroll
  for (int dt = 0; dt < 4; ++dt) { o[dt][0] = f32x4{0.f, 0.f, 0.f, 0.f}; o[dt][1] = f32x4{0.f, 0.f, 0.f, 0.f}; }
  bf16x8 kc[4][2], kn[4][2], vc[2][4];
  {
    const u16* Kc0 = K + (size_t)((q0 + 31) >> 6) * 64 * 64;
#pragma unroll
    for (int kt = 0; kt < 4; ++kt)
#pragma unroll
      for (int ks = 0; ks < 2; ++ks) kc[kt][ks] = ld8(Kc0 + (size_t)(kt * 16 + lr) * 64 + ks * 32 + quad * 8);
  }
  for (int chk = (q0 + 31) >> 6; chk >= 0; --chk) {
    const int cb = chk * 64;
    {
      const u16* Vc = Vt + (size_t)chk * 2 * 64 * 32;
#pragma unroll
      for (int g = 0; g < 2; ++g)
#pragma unroll
        for (int dt = 0; dt < 4; ++dt) vc[g][dt] = ld8(Vc + ((size_t)((g * 4 + dt) * 16 + lr) * 4 + quad) * 8);
    }
    if (chk > 0) {
      const u16* Kn = K + (size_t)(chk - 1) * 64 * 64;
#pragma unroll
      for (int kt = 0; kt < 4; ++kt)
#pragma unroll
        for (int ks = 0; ks < 2; ++ks) kn[kt][ks] = ld8(Kn + (size_t)(kt * 16 + lr) * 64 + ks * 32 + quad * 8);
    }
    f32x4 st[4][2];
#pragma unroll
    for (int kt = 0; kt < 4; ++kt) {
      st[kt][0] = f32x4{0.f, 0.f, 0.f, 0.f}; st[kt][1] = f32x4{0.f, 0.f, 0.f, 0.f};
#pragma unroll
      for (int ks = 0; ks < 2; ++ks) { st[kt][0] = mfma16(kc[kt][ks], qf[0][ks], st[kt][0]); st[kt][1] = mfma16(kc[kt][ks], qf[1][ks], st[kt][1]); }
    }
#pragma unroll
    for (int c = 0; c < 2; ++c) {
      const int t = q0 + c * 16 + lr;
      float lk[4][4], hq[4], tot[4];
#pragma unroll
      for (int kt = 0; kt < 4; ++kt) {
        float g = 0.f;
#pragma unroll
        for (int j = 0; j < 4; ++j) {
          const int key = cb + kt * 16 + quad * 4 + j;
          const float z = st[kt][c][j];
          const float sp = fmaxf(z, 0.f) + flog(1.f + fexp(-fabsf(z)));
          const float v = (key < t) ? -sp : 0.f;
          lk[kt][j] = v; g += v;
        }
        const auto r16 = __builtin_amdgcn_permlane16_swap(__float_as_uint(g), __float_as_uint(g), false, false);
        const float od = __uint_as_float(r16[1]);
        const float psum = __uint_as_float(r16[0]) + od;
        const auto r32 = __builtin_amdgcn_permlane32_swap(__float_as_uint(psum), __float_as_uint(psum), false, false);
        const float p01 = __uint_as_float(r32[0]), p23 = __uint_as_float(r32[1]);
        hq[kt] = (quad == 0) ? (od + p23) : (quad == 1) ? p23 : (quad == 2) ? od : 0.f;
        tot[kt] = p01 + p23;
      }
      float run = carry[c];
#pragma unroll
      for (int kt = 3; kt >= 0; --kt) {
        const float base = run + hq[kt];
        float ex = 0.f;
#pragma unroll
        for (int j = 3; j >= 0; --j) {
          const int key = cb + kt * 16 + quad * 4 + j;
          const float z = st[kt][c][j];
          const float a = (key < t) ? fexp(z + lk[kt][j] + base + ex) : 0.f;
          st[kt][c][j] = a;
          ex += lk[kt][j];
        }
        run += tot[kt];
      }
      carry[c] = run;
    }
    bf16x8 pb[2][2];
#pragma unroll
    for (int c = 0; c < 2; ++c)
#pragma unroll
      for (int g = 0; g < 2; ++g)
        pb[c][g] = pack8(st[2 * g][c][0], st[2 * g][c][1], st[2 * g][c][2], st[2 * g][c][3],
                         st[2 * g + 1][c][0], st[2 * g + 1][c][1], st[2 * g + 1][c][2], st[2 * g + 1][c][3]);
#pragma unroll
    for (int g = 0; g < 2; ++g)
#pragma unroll
      for (int dt = 0; dt < 4; ++dt) {
        o[dt][0] = mfma16(vc[g][dt], pb[0][g], o[dt][0]);
        o[dt][1] = mfma16(vc[g][dt], pb[1][g], o[dt][1]);
      }
#pragma unroll
    for (int kt = 0; kt < 4; ++kt) { kc[kt][0] = kn[kt][0]; kc[kt][1] = kn[kt][1]; }
    if (__all((carry[0] < -104.f) && (carry[1] < -104.f))) break;
  }
  const float inv[2] = {1.f, 1.f};
  write_og4(p, o, inv, b, q0, 512 + h * 64, lane);
}

DEV int wave_sum_dpp(int v) {
  int x = v;
  x += __builtin_amdgcn_update_dpp(0, x, 0x111, 0xf, 0xf, false);
  x += __builtin_amdgcn_update_dpp(0, x, 0x112, 0xf, 0xf, false);
  x += __builtin_amdgcn_update_dpp(0, x, 0x114, 0xf, 0xf, false);
  x += __builtin_amdgcn_update_dpp(0, x, 0x118, 0xf, 0xf, false);
  x += __builtin_amdgcn_update_dpp(0, x, 0x142, 0xa, 0xf, false);
  x += __builtin_amdgcn_update_dpp(0, x, 0x143, 0xc, 0xf, false);
  return __builtin_amdgcn_readlane(x, 63);
}
DEV u16 key16(float s) { u16 u = f2bf(s); return (u & 0x8000u) ? (u16)(~u) : (u16)(u | 0x8000u); }

DEV void dsa_item(const Params& p, int b, int tile16, char* smem, int tid) {
  u16* keys = reinterpret_cast<u16*>(smem);
  u64* maskL = reinterpret_cast<u64*>(smem + 65536);
  const int wave = tid >> 6, lane = tid & 63, lr = lane & 15, quad = lane >> 4;
  const int t0 = tile16 * 16;
  const int nch = ((t0 + 15) >> 6) + 1;
  const size_t tb = (size_t)b * SEQ;
#if DBL == 10
  for (int half2 = 0; half2 < 4; ++half2) {
    const int half = half2 & 1;
#elif DBL == 12
  for (int half2 = 0; half2 < 2; ++half2) {
    const int half = half2;
#else
  for (int half = 0; half < 2; ++half) {
#endif
    const int qh0 = t0 + half * 8;
#if DBL == 12
    for (int rep = 0; rep < 2; ++rep)
#endif
    {
      bf16x8 ax[2], ay[2]; float wx[2][4], wy[2][4];
#pragma unroll
      for (int pr = 0; pr < 2; ++pr) {
        const int q = qh0 + pr * 4 + (lr >> 2);
        ax[pr] = ld8(P_IQ + ((tb + q) * 8 + (lr & 3)) * 32 + quad * 8);
        ay[pr] = ld8(P_IQ + ((tb + q) * 8 + 4 + (lr & 3)) * 32 + quad * 8);
        const int qo = qh0 + pr * 4 + quad;
        const float4 w0 = *reinterpret_cast<const float4*>(P_IW + (tb + qo) * 8);
        const float4 w1 = *reinterpret_cast<const float4*>(P_IW + (tb + qo) * 8 + 4);
        wx[pr][0] = w0.x; wx[pr][1] = w0.y; wx[pr][2] = w0.z; wx[pr][3] = w0.w;
        wy[pr][0] = w1.x; wy[pr][1] = w1.y; wy[pr][2] = w1.z; wy[pr][3] = w1.w;
      }
      for (int tile = wave; tile < ((nch + 1) >> 1) * 8; tile += 4) {
        const int key = tile * 16 + lr;
        const bf16x8 kf = ld8(P_IK + (tb + key) * 32 + quad * 8);
#pragma unroll
        for (int pr = 0; pr < 2; ++pr) {
          f32x4 X = mfma16(ax[pr], kf, f32x4{0.f, 0.f, 0.f, 0.f});
          f32x4 Y = mfma16(ay[pr], kf, f32x4{0.f, 0.f, 0.f, 0.f});
          float sc = 0.f;
#pragma unroll
          for (int j = 0; j < 4; ++j) { sc = fmaf(fmaxf(X[j], 0.f), wx[pr][j], sc); sc = fmaf(fmaxf(Y[j], 0.f), wy[pr][j], sc); }
          const int qo = qh0 + pr * 4 + quad;
          keys[(pr * 4 + quad) * 4096 + (key & ~127) + ((key & 63) << 1) + ((key >> 6) & 1)] = (key <= qo) ? key16(sc) : (u16)0;
        }
      }
    }
    __syncthreads();
    {
      const int qiA = wave * 2, qiB = wave * 2 + 1;
      const unsigned* kpA = reinterpret_cast<const unsigned*>(keys + qiA * 4096) + lane;
      const unsigned* kpB = reinterpret_cast<const unsigned*>(keys + qiB * 4096) + lane;
      const int nrd = (nch + 1) >> 1;
      unsigned TA = 0u, TB = 0u;
      for (int bit = 15; bit >= 0; --bit) {
        const unsigned cA = TA | (1u << bit), cB = TB | (1u << bit);
        int nA = 0, nB = 0;
#pragma unroll 4
        for (int r = 0; r < nrd; ++r) {
          const unsigned ka = kpA[r * 64], kb = kpB[r * 64];
          nA += ((ka & 0xFFFFu) >= cA) + ((ka >> 16) >= cA);
          nB += ((kb & 0xFFFFu) >= cB) + ((kb >> 16) >= cB);
        }
        const int pk = wave_sum_dpp(nA | (nB << 16));
        if ((pk & 0xFFFF) >= 256) TA = cA;
        if ((pk >> 16) >= 256) TB = cB;
      }
#pragma unroll
      for (int qq = 0; qq < 2; ++qq) {
        const unsigned T = qq ? TB : TA;
        const unsigned* kp = qq ? kpB : kpA;
        const int qi = wave * 2 + qq;
        int gl = 0;
#pragma unroll 4
        for (int r = 0; r < nrd; ++r) { const unsigned kv = kp[r * 64]; gl += ((kv & 0xFFFFu) > T) + ((kv >> 16) > T); }
        gl = wave_sum_dpp(gl);
        const int need = (T > 0u) ? (256 - gl) : 0;
        int running = 0;
        const u64 lt_mask = (lane == 0) ? 0ull : (~0ull >> (64 - lane));
        for (int r = 0; r < nrd; ++r) {
          const unsigned kv = kp[r * 64];
#pragma unroll
          for (int hf = 0; hf < 2; ++hf) {
            const unsigned kk = hf ? (kv >> 16) : (kv & 0xFFFFu);
            const bool eq = (T > 0u) && (kk == T);
            const u64 beq = __ballot(eq);
            const int rank = running + __popcll(beq & lt_mask);
            const bool sel = (kk > T) || (eq && rank < need);
            const u64 msk = __ballot(sel);
            running += __popcll(beq);
            if (lane == 0) maskL[(half * 8 + qi) * 64 + r * 2 + hf] = msk;
          }
        }
      }
    }
    __syncthreads();
  }
  {
    char* gbuf = smem + wave * 10752;
    u16* idxL = reinterpret_cast<u16*>(smem + 43008 + wave * 1088);
    unsigned char* flL = reinterpret_cast<unsigned char*>(smem + 47360 + wave * 544);
    const u64 lt_mask2 = (lane == 0) ? 0ull : (~0ull >> (64 - lane));
    const unsigned trbase = (unsigned)(size_t)gbuf + (unsigned)((quad * 4 + ((lane & 15) >> 2)) * 336 + (lane & 3) * 8);
    for (int pp = 0; pp < 2; ++pp) {
      const int pair = wave * 2 + pp;
      int n = 0;
      for (int ch = 0; ch < nch; ++ch) {
        const u64 ma = maskL[(pair * 2) * 64 + ch], mb = maskL[(pair * 2 + 1) * 64 + ch];
        const u64 u = ma | mb;
        if (u == 0ull) continue;
        if ((u >> lane) & 1ull) {
          const int pos = n + __popcll(u & lt_mask2);
          idxL[pos] = (u16)(ch * 64 + lane);
          flL[pos] = (unsigned char)(((ma >> lane) & 1ull) | (((mb >> lane) & 1ull) << 1));
        }
        n += __popcll(u);
      }
      const int npad = (n + 31) & ~31;
      if (lane < npad - n) { idxL[n + lane] = 0; flL[n + lane] = 0; }
      const int ngr = npad >> 5;
      bf16x8 qf[5];
#pragma unroll
      for (int ks = 0; ks < 5; ++ks) qf[ks] = ld8(P_QC + ((tb + t0 + pair * 2 + (lr >> 3)) * 8 + (lr & 7)) * 160 + ks * 32 + quad * 8);
      float m = NEG_INF, l = 0.f;
      f32x4 o[8];
#pragma unroll
      for (int dt = 0; dt < 8; ++dt) o[dt] = f32x4{0.f, 0.f, 0.f, 0.f};
      const int qsel = lr >> 3;
      uint4 gv0, gv1, gv2, gv3, gv4, gv5, gv6, gv7, gv8, gv9;
#define GLOAD(I, G) do { const int pc_ = lane + 64 * (I); const int slot_ = pc_ / 20, piece_ = pc_ - slot_ * 20; \
        const int key_ = idxL[(G) * 32 + slot_]; gv##I = *reinterpret_cast<const uint4*>(P_KVC + (tb + key_) * 160 + piece_ * 8); } while (0)
#define GSTORE(I) do { const int pc_ = lane + 64 * (I); const int slot_ = pc_ / 20, piece_ = pc_ - slot_ * 20; \
        *reinterpret_cast<uint4*>(gbuf + slot_ * 336 + piece_ * 16) = gv##I; } while (0)
      if (ngr > 0) { GLOAD(0, 0); GLOAD(1, 0); GLOAD(2, 0); GLOAD(3, 0); GLOAD(4, 0); GLOAD(5, 0); GLOAD(6, 0); GLOAD(7, 0); GLOAD(8, 0); GLOAD(9, 0); }
      else { gv0 = gv1 = gv2 = gv3 = gv4 = gv5 = gv6 = gv7 = gv8 = gv9 = make_uint4(0u, 0u, 0u, 0u); }
      for (int g = 0; g < ngr; ++g) {
        GSTORE(0); GSTORE(1); GSTORE(2); GSTORE(3); GSTORE(4); GSTORE(5); GSTORE(6); GSTORE(7); GSTORE(8); GSTORE(9);
        if (g + 1 < ngr) { GLOAD(0, g + 1); GLOAD(1, g + 1); GLOAD(2, g + 1); GLOAD(3, g + 1); GLOAD(4, g + 1); GLOAD(5, g + 1); GLOAD(6, g + 1); GLOAD(7, g + 1); GLOAD(8, g + 1); GLOAD(9, g + 1); }
        f32x4 st[2];
#pragma unroll
        for (int kt = 0; kt < 2; ++kt) {
          st[kt] = f32x4{0.f, 0.f, 0.f, 0.f};
#pragma unroll
          for (int ks = 0; ks < 5; ++ks) {
            bf16x8 kf = *reinterpret_cast<const bf16x8*>(gbuf + (kt * 16 + lr) * 336 + ks * 64 + quad * 16);
            st[kt] = mfma16(kf, qf[ks], st[kt]);
          }
        }
        float cm = NEG_INF;
#pragma unroll
        for (int kt = 0; kt < 2; ++kt) {
          const unsigned fw = *reinterpret_cast<const unsigned*>(flL + g * 32 + kt * 16 + quad * 4);
#pragma unroll
          for (int j = 0; j < 4; ++j) {
            const bool v = ((fw >> (8 * j + qsel)) & 1u) != 0u;
            const float sv = v ? st[kt][j] : NEG_INF;
            st[kt][j] = sv; cm = fmaxf(cm, sv);
          }
        }
        cm = xq_max(cm);
        if (!__all(cm <= m + 8.f)) {
          const float mn = fmaxf(m, cm);
          const float msn = (mn == NEG_INF) ? 0.f : mn;
          const float alpha = fexp2(m - msn);
          m = mn;
          l *= alpha;
#pragma unroll
          for (int dt = 0; dt < 8; ++dt) { o[dt][0] *= alpha; o[dt][1] *= alpha; o[dt][2] *= alpha; o[dt][3] *= alpha; }
        }
        const float ms = (m == NEG_INF) ? 0.f : m;
        float ps = 0.f;
#pragma unroll
        for (int kt = 0; kt < 2; ++kt)
#pragma unroll
          for (int j = 0; j < 4; ++j) { const float pv = fexp2(st[kt][j] - ms); st[kt][j] = pv; ps += pv; }
        l += ps;
        const bf16x8 pb = pack8(st[0][0], st[0][1], st[0][2], st[0][3], st[1][0], st[1][1], st[1][2], st[1][3]);
        uint2 ta[8], tc[8];
        asm volatile(
            "s_waitcnt lgkmcnt(0)\n\t"
            "ds_read_b64_tr_b16 %0, %16\n\t"
            "ds_read_b64_tr_b16 %1, %16 offset:32\n\t"
            "ds_read_b64_tr_b16 %2, %16 offset:64\n\t"
            "ds_read_b64_tr_b16 %3, %16 offset:96\n\t"
            "ds_read_b64_tr_b16 %4, %16 offset:128\n\t"
            "ds_read_b64_tr_b16 %5, %16 offset:160\n\t"
            "ds_read_b64_tr_b16 %6, %16 offset:192\n\t"
            "ds_read_b64_tr_b16 %7, %16 offset:224\n\t"
            "ds_read_b64_tr_b16 %8, %16 offset:5376\n\t"
            "ds_read_b64_tr_b16 %9, %16 offset:5408\n\t"
            "ds_read_b64_tr_b16 %10, %16 offset:5440\n\t"
            "ds_read_b64_tr_b16 %11, %16 offset:5472\n\t"
            "ds_read_b64_tr_b16 %12, %16 offset:5504\n\t"
            "ds_read_b64_tr_b16 %13, %16 offset:5536\n\t"
            "ds_read_b64_tr_b16 %14, %16 offset:5568\n\t"
            "ds_read_b64_tr_b16 %15, %16 offset:5600\n\t"
            "s_waitcnt lgkmcnt(0)"
            : "=&v"(ta[0]), "=&v"(ta[1]), "=&v"(ta[2]), "=&v"(ta[3]), "=&v"(ta[4]), "=&v"(ta[5]), "=&v"(ta[6]), "=&v"(ta[7]),
              "=&v"(tc[0]), "=&v"(tc[1]), "=&v"(tc[2]), "=&v"(tc[3]), "=&v"(tc[4]), "=&v"(tc[5]), "=&v"(tc[6]), "=&v"(tc[7])
            : "v"(trbase)
            : "memory");
#pragma unroll
        for (int dt = 0; dt < 8; ++dt) {
          union { bf16x8 v; unsigned u[4]; } vf;
          vf.u[0] = ta[dt].x; vf.u[1] = ta[dt].y; vf.u[2] = tc[dt].x; vf.u[3] = tc[dt].y;
          o[dt] = mfma16(vf.v, pb, o[dt]);
        }
      }
      const float inv = 1.f / quad_sum(l);
      u16* op = P_OLAT + ((tb + t0 + pair * 2 + qsel) * 8 + (lr & 7)) * 128 + quad * 4;
#pragma unroll
      for (int dt = 0; dt < 8; ++dt) st8b(op + dt * 16, o[dt][0] * inv, o[dt][1] * inv, o[dt][2] * inv, o[dt][3] * inv);
    }
  }
  __threadfence_block();
  __syncthreads();
#pragma unroll
  for (int c = 0; c < 2; ++c) {
    const int h = wave * 2 + c;
    f32x4 res[4];
#pragma unroll
    for (int dvt = 0; dvt < 4; ++dvt) res[dvt] = f32x4{0.f, 0.f, 0.f, 0.f};
#pragma unroll
    for (int g = 0; g < 4; ++g) {
      const bf16x8 pbv = ld8(P_OLAT + ((tb + t0 + lr) * 8 + h) * 128 + g * 32 + quad * 8);
#pragma unroll
      for (int dvt = 0; dvt < 4; ++dvt) {
        const bf16x8 wf = ld8(P_WUVp + ((size_t)(h * 64 + dvt * 16 + lr)) * 128 + g * 32 + quad * 8);
        res[dvt] = mfma16(wf, pbv, res[dvt]);
      }
    }
    const size_t base = (tb + t0 + lr) * 1024 + h * 64 + quad * 4;
#pragma unroll
    for (int dvt = 0; dvt < 4; ++dvt) {
      uint2 sg = *reinterpret_cast<const uint2*>(P_SG + base + dvt * 16);
      float g0 = bf2f((u16)(sg.x & 0xFFFF)), g1 = bf2f((u16)(sg.x >> 16)), g2 = bf2f((u16)(sg.y & 0xFFFF)), g3 = bf2f((u16)(sg.y >> 16));
      st8b(P_OG + base + dvt * 16, res[dvt][0] * g0, res[dvt][1] * g1, res[dvt][2] * g2, res[dvt][3] * g3);
    }
  }
}

DEV void phase_attn(const Params& p, int layer, char* smem, int tid_in, int ctr_idx, int it_lo, int it_hi) {
  int* s_item = reinterpret_cast<int*>(smem + 73728);
  for (;;) {
    const int tid = opq(tid_in);
    const int wave = tid >> 6, lane = tid & 63;
    if (tid == 0) *s_item = atomicAdd(P_ctr + ctr_idx, 1);
    __syncthreads();
    const int it = *s_item + it_lo;
    __syncthreads();
    if (it >= it_hi) break;
    if (layer == 0) {
      if (it < 1024) { const int qt = 31 - (it >> 5), bh = it & 31; moba_item(p, bh >> 3, bh & 7, qt, wave, lane, smem); }
      else { const int i = it - 1024; const int t32 = i >> 3, bk = i & 7; swa_item(p, bk >> 1, bk & 1, t32, wave, lane, smem); }
    } else {
      if (it < 1024) { const int tile16 = 255 - (it >> 2), b = it & 3; dsa_item(p, b, tile16, smem, tid); }
      else { const int i = it - 1024; const int qt = i >> 5, bh = i & 31; sb_item(p, bh >> 3, bh & 7, qt, wave, lane); }
    }
  }
}

__global__ void __launch_bounds__(256, 2) fwd_megakernel(Params p) {
  __shared__ __attribute__((aligned(16))) char smem[73728 + 64];
  cg::grid_group grid = cg::this_grid();
  __shared__ uint4 xb_words;
  if (threadIdx.x == 0) xb_words = make_uint4(0u, 0u, 0u, 0u);
  __syncthreads();
  XcdBarrier xb = xcd_barrier_post(P_bar, (volatile LAS unsigned*)&xb_words);
  if (p.out == nullptr) grid.sync();
#define OPQ_TID() ({ int t_; asm volatile("v_mov_b32 %0, %1" : "=v"(t_) : "v"((int)threadIdx.x)); t_; })
#define GSYNC() xcd_barrier(xb)
#define VID() ((int)((volatile LAS unsigned*)&xb_words)[3])
  phase0(p, smem, OPQ_TID());
  GSYNC();
  phase_prep(p, 0, OPQ_TID());
  GSYNC();
  phase_inproj(p, 0, smem, OPQ_TID(), VID());
#if DBL == 1
  GSYNC(); phase_inproj(p, 0, smem, OPQ_TID(), VID());
#endif
  GSYNC();
  phase_attn(p, 0, smem, OPQ_TID(), 0, 0, 2048);
#if DBL == 2
  GSYNC(); phase_attn(p, 0, smem, OPQ_TID(), 2, 0, 1024);
#elif DBL == 7
  GSYNC(); phase_attn(p, 0, smem, OPQ_TID(), 2, 1024, 2048);
#endif
  GSYNC();
  phase_outproj(p, 0, smem, OPQ_TID(), VID());
#if DBL == 3
  GSYNC(); phase_outproj(p, 0, smem, OPQ_TID(), VID());
#endif
  GSYNC();
  phase_prep(p, 1, OPQ_TID());
  GSYNC();
  phase_inproj(p, 1, smem, OPQ_TID(), VID());
#if DBL == 4
  GSYNC(); phase_inproj(p, 1, smem, OPQ_TID(), VID());
#endif
  GSYNC();
  phase_attn(p, 1, smem, OPQ_TID(), 1, 0, 2048);
#if DBL == 5
  GSYNC(); phase_attn(p, 1, smem, OPQ_TID(), 3, 0, 1024);
#elif DBL == 6
  GSYNC(); phase_attn(p, 1, smem, OPQ_TID(), 3, 1024, 2048);
#endif
  GSYNC();
  phase_outproj(p, 1, smem, OPQ_TID(), VID());
  GSYNC();
  phase_final_ln(p, OPQ_TID());
}

extern "C" void kernel_launch(void* const* d_in, const int* in_sizes, int n_in, void* d_out, int out_size,
                              void* d_ws, size_t ws_size, hipStream_t stream) {
  static int grid_blocks = 0;
  if (!grid_blocks) {
    int dev = 0, cus = 0, per_cu = 0;
    hipGetDevice(&dev);
    hipDeviceGetAttribute(&cus, hipDeviceAttributeMultiprocessorCount, dev);
    hipOccupancyMaxActiveBlocksPerMultiprocessor(&per_cu, fwd_megakernel, 256, 0);
    if (per_cu < 1) per_cu = 1;
    if (per_cu > 2) per_cu = 2;
    grid_blocks = cus * per_cu;
  }
  Params p{};
  p.x = (const float*)d_in[0]; p.c = (const float*)d_in[1]; p.w_ada = (const float*)d_in[2]; p.b_ada = (const float*)d_in[3];
  p.w_in_even = (const float*)d_in[4]; p.sinks = (const float*)d_in[5]; p.w_in_odd = (const float*)d_in[6]; p.kvg = (const float*)d_in[7];
  p.w_uk = (const float*)d_in[8]; p.w_uv = (const float*)d_in[9]; p.w_out = (const float*)d_in[10]; p.ln_g = (const float*)d_in[11]; p.ln_b = (const float*)d_in[12];
  p.out = (float*)d_out;
  p.ws = (char*)d_ws;
  if (WS_NEEDED > ws_size) { fprintf(stderr, "workspace too small: need %zu have %zu\n", (size_t)WS_NEEDED, ws_size); return; }
  hipMemsetAsync(p.ws + 24871168ull, 0, (size_t)XCD_BAR_WORDS * 4, stream);
  void* args[] = {&p};
  hipError_t e = hipLaunchCooperativeKernel((void*)fwd_megakernel, dim3(grid_blocks), dim3(256), args, 0, stream);
  if (e != hipSuccess) fprintf(stderr, "cooperative launch failed: %s (grid %d)\n", hipGetErrorString(e), grid_blocks);
}
```

```cpp
#include <hip/hip_runtime.h>
#include <hip/hip_cooperative_groups.h>
#include <cstdio>
namespace cg = cooperative_groups;

typedef unsigned short u16;
typedef unsigned long long u64;
typedef __attribute__((ext_vector_type(8))) short bf16x8;
typedef __attribute__((ext_vector_type(4))) float f32x4;

#define DBL 0
#define DEV __device__ __forceinline__
#define NEG_INF (-__builtin_inff())

static constexpr int SEQ = 4096;
static constexpr int NTOK = 16384;
static constexpr int DM = 1024;
static constexpr int EVEN_IN = 3328;
static constexpr int ODD_IN = 3784;
static constexpr int ODD_N = 4352;
static constexpr float LOG2E = 1.4426950408889634f;
static constexpr float LN_EPS = 1e-5f;
static constexpr float DN_ALPHA = 1.4142135623730951f;

struct Params {
  const float *x, *c, *w_ada, *b_ada, *w_in_even, *sinks, *w_in_odd, *kvg, *w_uk, *w_uv, *w_out, *ln_g, *ln_b;
  float* out;
  char* ws;
};
#define P_WTe (reinterpret_cast<u16*>(p.ws + 0ull))
#define P_WTo (reinterpret_cast<u16*>(p.ws + 6815744ull))
#define P_WOT (reinterpret_cast<u16*>(p.ws + 15728640ull))
#define P_WUVp (reinterpret_cast<u16*>(p.ws + 19922944ull))
#define P_mods (reinterpret_cast<float*>(p.ws + 20054016ull))
#define P_cos64 (reinterpret_cast<float*>(p.ws + 20152320ull))
#define P_sin64 (reinterpret_cast<float*>(p.ws + 20676608ull))
#define P_cos32 (reinterpret_cast<float*>(p.ws + 21200896ull))
#define P_sin32 (reinterpret_cast<float*>(p.ws + 21463040ull))
#define P_kpart (reinterpret_cast<float*>(p.ws + 21725184ull))
#define P_stats0 (reinterpret_cast<float*>(p.ws + 22249472ull))
#define P_stats1 (reinterpret_cast<float*>(p.ws + 23298048ull))
#define P_IW (reinterpret_cast<float*>(p.ws + 24346624ull))
#define P_ctr (reinterpret_cast<int*>(p.ws + 24870912ull))
#define P_bar (reinterpret_cast<unsigned*>(p.ws + 24871168ull))
#define P_SG (reinterpret_cast<u16*>(p.ws + 24884992ull))
#define P_OG (reinterpret_cast<u16*>(p.ws + 58439424ull))
#define P_AQ (reinterpret_cast<u16*>(p.ws + 91993856ull))
#define P_AK (reinterpret_cast<u16*>(p.ws + 108771072ull))
#define P_AVt (reinterpret_cast<u16*>(p.ws + 125548288ull))
#define P_BQ (reinterpret_cast<u16*>(p.ws + 142325504ull))
#define P_BKk (reinterpret_cast<u16*>(p.ws + 159102720ull))
#define P_BVt (reinterpret_cast<u16*>(p.ws + 163297024ull))
#define P_QC (reinterpret_cast<u16*>(p.ws + 91993856ull))
#define P_KVC (reinterpret_cast<u16*>(p.ws + 133936896ull))
#define P_CKVt (reinterpret_cast<u16*>(p.ws + 139179776ull))
#define P_IQ (reinterpret_cast<u16*>(p.ws + 143374080ull))
#define P_IK (reinterpret_cast<u16*>(p.ws + 151762688ull))
#define P_DQ (reinterpret_cast<u16*>(p.ws + 152811264ull))
#define P_DK (reinterpret_cast<u16*>(p.ws + 169588480ull))
#define P_DVt (reinterpret_cast<u16*>(p.ws + 186365696ull))
#define P_OLAT (reinterpret_cast<u16*>(p.ws + 203142912ull))
#define P_H (reinterpret_cast<u16*>(p.ws + 203142912ull))
static constexpr size_t WS_NEEDED = 236697344ull;

DEV int opq(int x) { asm volatile("" : "+v"(x)); return x; }
DEV u16 f2bf(float f) { unsigned u = __float_as_uint(f); u += 0x7FFFu + ((u >> 16) & 1u); return (u16)(u >> 16); }
DEV float bf2f(u16 h) { return __uint_as_float(((unsigned)h) << 16); }
DEV unsigned pack2(float a, float b) { unsigned r; asm("v_cvt_pk_bf16_f32 %0, %1, %2" : "=v"(r) : "v"(a), "v"(b)); return r; }
DEV bf16x8 pack8(float a0, float a1, float a2, float a3, float a4, float a5, float a6, float a7) {
  union { bf16x8 v; unsigned u[4]; } r;
  r.u[0] = pack2(a0, a1); r.u[1] = pack2(a2, a3); r.u[2] = pack2(a4, a5); r.u[3] = pack2(a6, a7);
  return r.v;
}
DEV bf16x8 ld8(const u16* p) { return *reinterpret_cast<const bf16x8*>(p); }
DEV f32x4 mfma16(bf16x8 a, bf16x8 b, f32x4 c) { return __builtin_amdgcn_mfma_f32_16x16x32_bf16(a, b, c, 0, 0, 0); }
DEV float fexp2(float x) { return __builtin_amdgcn_exp2f(x); }
DEV float fexp(float x) { return __builtin_amdgcn_exp2f(x * LOG2E); }
DEV float flog(float x) { return __builtin_amdgcn_logf(x) * 0.6931471805599453f; }
DEV float silu_f(float x) { return x / (1.f + fexp(-x)); }
DEV void st8b(u16* p, float a, float b, float c, float d) { uint2 v; v.x = pack2(a, b); v.y = pack2(c, d); *reinterpret_cast<uint2*>(p) = v; }
DEV void st16b(u16* p, const float* v) { uint4 u; u.x = pack2(v[0], v[1]); u.y = pack2(v[2], v[3]); u.z = pack2(v[4], v[5]); u.w = pack2(v[6], v[7]); *reinterpret_cast<uint4*>(p) = u; }


#define XB_TMO      128
#define XB_XCNT(j)  (256  + 64 * (j))
#define XB_XSUB(j)  (1280 + 64 * (j))
#define XB_XGEN(j)  (2304 + 64 * (j))
#define XB_TOP      3328
#define XB_TOPGEN   3392
#define XCD_BAR_WORDS 3456
#define XB_SPIN_CAP (1u << 18)
#define LAS __attribute__((address_space(3)))
DEV unsigned xb_ld(unsigned* p)              { return __hip_atomic_load(p, __ATOMIC_RELAXED, __HIP_MEMORY_SCOPE_AGENT); }
DEV unsigned xb_add(unsigned* p, unsigned v) { return __hip_atomic_fetch_add(p, v, __ATOMIC_RELAXED, __HIP_MEMORY_SCOPE_AGENT); }
DEV unsigned xb_xcc_id() { return (unsigned)__builtin_amdgcn_s_getreg((3 << 11) | 20) & 0xFu; }
#define XB_SPIN(cond, bar) do { unsigned _sp = 0; while (cond) { __builtin_amdgcn_s_sleep(1); \
    if ((++_sp & 255u) == 0u) { if (xb_ld(&(bar)[XB_TMO])) break; if (_sp > XB_SPIN_CAP) { atomicAdd(&(bar)[XB_TMO], 1u); break; } } } } while (0)
struct XcdBarrier { unsigned* bar; unsigned x; volatile LAS unsigned* st; };
DEV XcdBarrier xcd_barrier_post(unsigned* bar, volatile LAS unsigned* st) {
  XcdBarrier b; b.bar = bar; b.x = xb_xcc_id(); b.st = st;
  if (threadIdx.x == 0) st[2] = xb_add(&bar[XB_XCNT(b.x)], 1u);
  return b;
}
DEV void xcd_barrier_complete(unsigned* bar, unsigned x, unsigned& nloc, unsigned& nx, unsigned& before) {
  const unsigned G = gridDim.x * gridDim.y * gridDim.z;
  unsigned sum, cnt, mine, bef, sp = 0u;
  for (;;) {
    sum = 0u; cnt = 0u; mine = 0u; bef = 0u;
#pragma unroll
    for (unsigned j = 0; j < 16; ++j) { const unsigned c = xb_ld(&bar[XB_XCNT(j)]); sum += c; cnt += (c > 0u) ? 1u : 0u; mine = (j == x) ? c : mine; bef += (j < x) ? c : 0u; }
    if (sum == G) break;
    __builtin_amdgcn_s_sleep(1);
    if ((++sp & 255u) == 0u) { if (xb_ld(&bar[XB_TMO])) break; if (sp > XB_SPIN_CAP) { atomicAdd(&bar[XB_TMO], 1u); break; } }
  }
  nloc = mine > 0u ? mine : 1u; nx = cnt > 0u ? cnt : 1u; before = bef;
}
DEV void xcd_barrier(const XcdBarrier& b) {
  asm volatile("s_waitcnt vmcnt(0)" ::: "memory");
  __syncthreads();
  if (threadIdx.x == 0) {
    unsigned* bar = b.bar;
    __builtin_amdgcn_s_waitcnt(0);
    unsigned nloc = b.st[0], nx = b.st[1];
    if (nloc == 0u) { unsigned bef; xcd_barrier_complete(bar, b.x, nloc, nx, bef); b.st[0] = nloc; b.st[1] = nx; b.st[3] = bef + b.st[2]; }
    const unsigned old = xb_add(&bar[XB_XSUB(b.x)], 1u);
    const unsigned gen = old / nloc;
    if (old + 1u == (gen + 1u) * nloc) {
      __builtin_amdgcn_fence(__ATOMIC_RELEASE, "agent");
      asm volatile("s_waitcnt vmcnt(0)" ::: "memory");
      const unsigned og = xb_add(&bar[XB_TOP], 1u);
      const unsigned tg = og / nx;
      if (og + 1u == (tg + 1u) * nx) xb_add(&bar[XB_TOPGEN], 1u);
      else XB_SPIN(xb_ld(&bar[XB_TOPGEN]) == tg, bar);
      __builtin_amdgcn_fence(__ATOMIC_ACQUIRE, "agent");
      xb_add(&bar[XB_XGEN(b.x)], 1u);
      asm volatile("s_waitcnt vmcnt(0)" ::: "memory");
    } else {
      XB_SPIN(xb_ld(&bar[XB_XGEN(b.x)]) == gen, bar);
      __builtin_amdgcn_fence(__ATOMIC_ACQUIRE, "agent");
      asm volatile("s_waitcnt vmcnt(0)" ::: "memory");
    }
  }
  __syncthreads();
}

DEV int odd_srccol(int n) {
  if (n < 1024) return -1;
  if (n < 1280) return 512 + (n - 1024);
  if (n < 1408) return 768 + (n - 1280);
  if (n < 1536) { int j = n - 1408; if (j < 32) return 896 + j; if (j < 64) return 1184 + (j - 32); if (j < 72) return 1216 + (j - 64); return -1; }
  if (n < 1792) return 928 + (n - 1536);
  if (n < 3328) return 1224 + (n - 1792);
  return 2760 + (n - 3328);
}

DEV void p0_transpose(const float* __restrict__ src, int ld, int mapmode, u16* __restrict__ dst, int n0, int k0, float* tile, int tid) {
  const int n = tid & 63;
  const int dn = n0 + n;
  const int sc = mapmode ? odd_srccol(dn) : dn;
#pragma unroll
  for (int i = 0; i < 16; ++i) {
    int kr = (tid >> 6) + 4 * i;
    tile[kr * 65 + n] = (sc >= 0) ? src[(size_t)(k0 + kr) * ld + sc] : 0.f;
  }
  __syncthreads();
#pragma unroll
  for (int i = 0; i < 16; ++i) {
    int nr = (tid >> 6) + 4 * i;
    int k = tid & 63;
    dst[(size_t)(n0 + nr) * 1024 + k0 + k] = f2bf(tile[k * 65 + nr]);
  }
  __syncthreads();
}

DEV void phase0(const Params& p, char* smem, int tid_in) {
  float* fs = reinterpret_cast<float*>(smem);
  const int NITEM = 96 + 512 + 2176 + 64;
  for (int it = blockIdx.x; it < NITEM; it += gridDim.x) {
    const int tid = opq(tid_in);
    if (it < 96) {
      const int col0 = it * 64; const int l = col0 / 3072; const int n0 = col0 % 3072;
      float* sc = fs;
      float* red = fs + 4096;
      for (int e = tid; e < 4096; e += 256) sc[e] = silu_f(p.c[e]);
      __syncthreads();
      const int cgp = tid & 15, ks = tid >> 4;
      float acc[4][4];
#pragma unroll
      for (int b = 0; b < 4; ++b) for (int e = 0; e < 4; ++e) acc[b][e] = 0.f;
      const float* wp = p.w_ada + ((size_t)l * 1024 + ks * 64) * 3072 + n0 + cgp * 4;
#pragma unroll 8
      for (int k = 0; k < 64; ++k) {
        float4 w = *reinterpret_cast<const float4*>(wp + (size_t)k * 3072);
#pragma unroll
        for (int b = 0; b < 4; ++b) {
          float s = sc[b * 1024 + ks * 64 + k];
          acc[b][0] += s * w.x; acc[b][1] += s * w.y; acc[b][2] += s * w.z; acc[b][3] += s * w.w;
        }
      }
#pragma unroll
      for (int b = 0; b < 4; ++b) for (int e = 0; e < 4; ++e) red[(ks * 4 + b) * 64 + cgp * 4 + e] = acc[b][e];
      __syncthreads();
      {
        const int b = tid >> 6, n = tid & 63;
        float s = 0.f;
#pragma unroll
        for (int k2 = 0; k2 < 16; ++k2) s += red[(k2 * 4 + b) * 64 + n];
        P_mods[(size_t)(l * 4 + b) * 3072 + n0 + n] = s + p.b_ada[l * 3072 + n0 + n];
      }
      __syncthreads();
    } else if (it < 608) {
      const int i = it - 96; const int h = i >> 6; const int k0 = ((i >> 2) & 15) * 64; const int cq = i & 3;
      float* Wk = fs;
#pragma unroll
      for (int r = 0; r < 16; ++r) {
        int kk = (tid >> 6) + 4 * r; int d = tid & 63;
        Wk[kk * 65 + d] = p.w_in_odd[(size_t)(k0 + kk) * ODD_IN + h * 64 + d];
      }
      __syncthreads();
      const int kk = tid & 63; const int cgp = tid >> 6;
      float wk[64];
#pragma unroll
      for (int d = 0; d < 64; ++d) wk[d] = Wk[kk * 65 + d];
#pragma unroll 2
      for (int cc = 0; cc < 8; ++cc) {
        const int cidx = cq * 32 + cgp * 8 + cc;
        const float* uk = p.w_uk + ((size_t)(h * 128 + cidx)) * 64;
        float a = 0.f;
#pragma unroll
        for (int d = 0; d < 64; ++d) a += wk[d] * uk[d];
        P_WTo[(size_t)(h * 128 + cidx) * 1024 + k0 + kk] = f2bf(a);
      }
      __syncthreads();
    } else if (it < 608 + 2176) {
      const int i = it - 608;
      if (i < 832) { p0_transpose(p.w_in_even, EVEN_IN, 0, P_WTe, (i >> 4) * 64, (i & 15) * 64, fs, tid); }
      else if (i < 1664) { int j = i - 832; p0_transpose(p.w_in_odd, ODD_IN, 1, P_WTo, 1024 + (j >> 4) * 64, (j & 15) * 64, fs, tid); }
      else { int j = i - 1664; int l = j >> 8; int jj = j & 255; p0_transpose(p.w_out + (size_t)l * 1024 * 1024, 1024, 0, P_WOT + (size_t)l * 1024 * 1024, (jj >> 4) * 64, (jj & 15) * 64, fs, tid); }
    } else {
      const int i = it - 2784;
      const int gtid = i * 256 + tid; const int gstr = 64 * 256;
      if (gtid == 0) { P_ctr[0] = 0; P_ctr[1] = 0; P_ctr[2] = 0; P_ctr[3] = 0; }
      for (int e = gtid; e < 4096 * 32; e += gstr) {
        int pos = e >> 5, f = e & 31;
        float inv = 1.0f / powf(10000.f, (float)(2 * f) / 64.f);
        float ang = (float)pos * inv;
        double rev = (double)ang * 0.15915494309189535; rev -= floor(rev);
        float fr = (float)rev;
        P_cos64[e] = __builtin_amdgcn_cosf(fr); P_sin64[e] = __builtin_amdgcn_sinf(fr);
      }
      for (int e = gtid; e < 4096 * 16; e += gstr) {
        int pos = e >> 4, f = e & 15;
        float inv = 1.0f / powf(10000.f, (float)(2 * f) / 32.f);
        float ang = (float)pos * inv;
        double rev = (double)ang * 0.15915494309189535; rev -= floor(rev);
        float fr = (float)rev;
        P_cos32[e] = __builtin_amdgcn_cosf(fr); P_sin32[e] = __builtin_amdgcn_sinf(fr);
      }
      for (int e = gtid; e < 8 * 128 * 64; e += gstr) {
        int cidx = e & 127, dv = (e >> 7) & 63, h = e >> 13;
        P_WUVp[e] = f2bf(p.w_uv[((size_t)(h * 128 + cidx)) * 64 + dv]);
      }
    }
  }
}

static constexpr int LDA_S = 72;
static constexpr int CS_LD = 132;
static constexpr int ROWSTAT_OFF = 67584;

DEV void row_stats_from_partials(const float* __restrict__ stats, int row, float& mu, float& rstd) {
  const float4* sp = reinterpret_cast<const float4*>(stats + (size_t)row * 16);
  float s = 0.f, ss = 0.f;
#pragma unroll
  for (int i = 0; i < 4; ++i) { float4 v = sp[i]; s += v.x + v.z; ss += v.y + v.w; }
  mu = s * (1.f / 1024.f);
  float var = ss * (1.f / 1024.f) - mu * mu;
  rstd = rsqrtf(fmaxf(var, 0.f) + LN_EPS);
}

template <bool AF32>
DEV void gemm_mainloop(const void* __restrict__ Aptr, const u16* __restrict__ Bt, int m0, int n0,
                       const float* __restrict__ lng, const float* __restrict__ lnb,
                       const float* __restrict__ msc, const float* __restrict__ msh,
                       const float* __restrict__ stats, char* smem, f32x4 (&acc)[4][4], int tid) {
  float* rowstat = reinterpret_cast<float*>(smem + ROWSTAT_OFF);
  const int wave = tid >> 6, lane = tid & 63, lr = lane & 15, quad = lane >> 4;
  const int wm = wave >> 1, wn = wave & 1;
#pragma unroll
  for (int i = 0; i < 4; ++i)
#pragma unroll
    for (int j = 0; j < 4; ++j) acc[i][j] = f32x4{0.f, 0.f, 0.f, 0.f};

  float rmu0 = 0.f, rmu1 = 0.f, rmu2 = 0.f, rmu3 = 0.f, rmu4 = 0.f, rmu5 = 0.f, rmu6 = 0.f, rmu7 = 0.f;
  float rrs0 = 1.f, rrs1 = 1.f, rrs2 = 1.f, rrs3 = 1.f, rrs4 = 1.f, rrs5 = 1.f, rrs6 = 1.f, rrs7 = 1.f;
  if (AF32) {
    if (tid < 128) {
      float mu = 0.f, rs = 1.f;
      if (stats) row_stats_from_partials(stats, m0 + tid, mu, rs);
      rowstat[tid * 2] = mu; rowstat[tid * 2 + 1] = rs;
    }
    __syncthreads();
#define RS_LD(I) { int r = (tid >> 4) + 16 * I; rmu##I = rowstat[r * 2]; rrs##I = rowstat[r * 2 + 1]; }
    RS_LD(0) RS_LD(1) RS_LD(2) RS_LD(3) RS_LD(4) RS_LD(5) RS_LD(6) RS_LD(7)
#undef RS_LD
  }

  uint4 b0, b1, b2, b3, a0, a1, a2, a3;
  float4 f0, f1, f2, f3, f4, f5, f6, f7;
  const int brow = tid >> 3, bpc = tid & 7;
  const u16* bsrc = Bt + (size_t)(n0 + brow) * 1024 + bpc * 8;
  const u16* asrc16 = reinterpret_cast<const u16*>(Aptr) + (size_t)(m0 + brow) * 1024 + bpc * 8;
  const int acg = tid & 15, arow = tid >> 4;
  const float* asrc32 = reinterpret_cast<const float*>(Aptr) + (size_t)(m0 + arow) * 1024 + acg * 4;
  const int bst = brow * 128 + ((bpc ^ ((brow >> 1) & 7)) << 4);
  const int ast = arow * 128 + ((((acg >> 1) ^ ((arow >> 1) & 7))) << 4) + (acg & 1) * 8;
  const int fsw = (lr >> 1) & 7;
  const int ard = (wm * 64 + lr) * 128, brd = 16384 + (wn * 64 + lr) * 128;
  const int fo0 = ((quad ^ fsw) << 4), fo1 = (((4 + quad) ^ fsw) << 4);

#define GEMM_LOAD_TILE(KT) do { const int k0_ = (KT) * 64; \
    b0 = *reinterpret_cast<const uint4*>(bsrc + k0_); b1 = *reinterpret_cast<const uint4*>(bsrc + k0_ + 32 * 1024); \
    b2 = *reinterpret_cast<const uint4*>(bsrc + k0_ + 64 * 1024); b3 = *reinterpret_cast<const uint4*>(bsrc + k0_ + 96 * 1024); \
    if (AF32) { \
      f0 = *reinterpret_cast<const float4*>(asrc32 + (size_t)(0) * 1024 + k0_);  f1 = *reinterpret_cast<const float4*>(asrc32 + (size_t)(16) * 1024 + k0_); \
      f2 = *reinterpret_cast<const float4*>(asrc32 + (size_t)(32) * 1024 + k0_); f3 = *reinterpret_cast<const float4*>(asrc32 + (size_t)(48) * 1024 + k0_); \
      f4 = *reinterpret_cast<const float4*>(asrc32 + (size_t)(64) * 1024 + k0_); f5 = *reinterpret_cast<const float4*>(asrc32 + (size_t)(80) * 1024 + k0_); \
      f6 = *reinterpret_cast<const float4*>(asrc32 + (size_t)(96) * 1024 + k0_); f7 = *reinterpret_cast<const float4*>(asrc32 + (size_t)(112) * 1024 + k0_); \
    } else { \
      a0 = *reinterpret_cast<const uint4*>(asrc16 + k0_); a1 = *reinterpret_cast<const uint4*>(asrc16 + k0_ + 32 * 1024); \
      a2 = *reinterpret_cast<const uint4*>(asrc16 + k0_ + 64 * 1024); a3 = *reinterpret_cast<const uint4*>(asrc16 + k0_ + 96 * 1024); \
    } } while (0)
#define GEMM_AFF(FV, I) do { \
    float q0_ = ((FV).x - rmu##I) * rrs##I * G.x + Bv.x; float q1_ = ((FV).y - rmu##I) * rrs##I * G.y + Bv.y; \
    float q2_ = ((FV).z - rmu##I) * rrs##I * G.z + Bv.z; float q3_ = ((FV).w - rmu##I) * rrs##I * G.w + Bv.w; \
    uint2 pk_; pk_.x = pack2(q0_, q1_); pk_.y = pack2(q2_, q3_); \
    *reinterpret_cast<uint2*>(sb_ + ast + (I) * 2048) = pk_; } while (0)
#define GEMM_STORE_TILE(KT, STG) do { char* sb_ = smem + (STG) * 32768; \
      *reinterpret_cast<uint4*>(sb_ + 16384 + bst) = b0; *reinterpret_cast<uint4*>(sb_ + 16384 + bst + 4096) = b1; \
      *reinterpret_cast<uint4*>(sb_ + 16384 + bst + 8192) = b2; *reinterpret_cast<uint4*>(sb_ + 16384 + bst + 12288) = b3; \
      if (AF32) { \
        const int k = (KT) * 64 + acg * 4; \
        float4 sc = *reinterpret_cast<const float4*>(msc + k); \
        float4 sh = *reinterpret_cast<const float4*>(msh + k); \
        float4 G, Bv; \
        if (lng) { \
          float4 g = *reinterpret_cast<const float4*>(lng + k); \
          float4 bb = *reinterpret_cast<const float4*>(lnb + k); \
          G.x = g.x * (1.f + sc.x); G.y = g.y * (1.f + sc.y); G.z = g.z * (1.f + sc.z); G.w = g.w * (1.f + sc.w); \
          Bv.x = bb.x * (1.f + sc.x) + sh.x; Bv.y = bb.y * (1.f + sc.y) + sh.y; Bv.z = bb.z * (1.f + sc.z) + sh.z; Bv.w = bb.w * (1.f + sc.w) + sh.w; \
        } else { \
          G.x = 1.f + sc.x; G.y = 1.f + sc.y; G.z = 1.f + sc.z; G.w = 1.f + sc.w; \
          Bv = sh; \
        } \
        GEMM_AFF(f0, 0); GEMM_AFF(f1, 1); GEMM_AFF(f2, 2); GEMM_AFF(f3, 3); \
        GEMM_AFF(f4, 4); GEMM_AFF(f5, 5); GEMM_AFF(f6, 6); GEMM_AFF(f7, 7); \
      } else { \
        *reinterpret_cast<uint4*>(sb_ + bst) = a0; *reinterpret_cast<uint4*>(sb_ + bst + 4096) = a1; \
        *reinterpret_cast<uint4*>(sb_ + bst + 8192) = a2; *reinterpret_cast<uint4*>(sb_ + bst + 12288) = a3; \
      } } while (0)

  GEMM_LOAD_TILE(0);
  GEMM_STORE_TILE(0, 0);
  GEMM_LOAD_TILE(1);
  __syncthreads();
  for (int kt = 0; kt < 16; ++kt) {
    const int cur = kt & 1;
    if (kt + 1 < 16) GEMM_STORE_TILE(kt + 1, cur ^ 1);
    if (kt + 2 < 16) GEMM_LOAD_TILE(kt + 2);
    {
      const char* sb = smem + cur * 32768;
      bf16x8 af0[4], bf0[4], af1[4], bf1[4];
#pragma unroll
      for (int mi = 0; mi < 4; ++mi) af0[mi] = *reinterpret_cast<const bf16x8*>(sb + ard + mi * 2048 + fo0);
#pragma unroll
      for (int ni = 0; ni < 4; ++ni) bf0[ni] = *reinterpret_cast<const bf16x8*>(sb + brd + ni * 2048 + fo0);
#pragma unroll
      for (int mi = 0; mi < 4; ++mi) af1[mi] = *reinterpret_cast<const bf16x8*>(sb + ard + mi * 2048 + fo1);
#pragma unroll
      for (int ni = 0; ni < 4; ++ni) bf1[ni] = *reinterpret_cast<const bf16x8*>(sb + brd + ni * 2048 + fo1);
      __builtin_amdgcn_sched_barrier(0);
#pragma unroll
      for (int mi = 0; mi < 4; ++mi)
#pragma unroll
        for (int ni = 0; ni < 4; ++ni) acc[mi][ni] = mfma16(af0[mi], bf0[ni], acc[mi][ni]);
#pragma unroll
      for (int mi = 0; mi < 4; ++mi)
#pragma unroll
        for (int ni = 0; ni < 4; ++ni) acc[mi][ni] = mfma16(af1[mi], bf1[ni], acc[mi][ni]);
    }
    __syncthreads();
  }
}

DEV void stage_all(f32x4 (&acc)[4][4], float* Cs, int tid) {
  const int wave = tid >> 6, lane = tid & 63, lr = lane & 15, quad = lane >> 4;
  const int wm = wave >> 1, wn = wave & 1;
#pragma unroll
  for (int mi = 0; mi < 4; ++mi)
#pragma unroll
    for (int ni = 0; ni < 4; ++ni)
#pragma unroll
      for (int j = 0; j < 4; ++j) Cs[(wm * 64 + mi * 16 + quad * 4 + j) * CS_LD + wn * 64 + ni * 16 + lr] = acc[mi][ni][j];
}

DEV void ld8f(const float* src, float* v) {
  const float4 a = *reinterpret_cast<const float4*>(src), c = *reinterpret_cast<const float4*>(src + 4);
  v[0] = a.x; v[1] = a.y; v[2] = a.z; v[3] = a.w; v[4] = c.x; v[5] = c.y; v[6] = c.z; v[7] = c.w;
}

DEV void epi_rope64(const Params& p, float* Cs, u16* dst, int H, int h0, float scale, bool do_kpart, int b, int pos0, int tid) {
  const int pc = tid & 15, hh = pc >> 3, j0 = (pc & 7) * 4;
#pragma unroll
  for (int ps = 0; ps < 8; ++ps) {
    const int row = ps * 16 + (tid >> 4);
    const int pos = pos0 + row;
    float* cp = Cs + row * CS_LD + hh * 64 + j0;
    const float4 x1 = *reinterpret_cast<const float4*>(cp), x2 = *reinterpret_cast<const float4*>(cp + 32);
    const float4 c = *reinterpret_cast<const float4*>(P_cos64 + (size_t)pos * 32 + j0);
    const float4 sn = *reinterpret_cast<const float4*>(P_sin64 + (size_t)pos * 32 + j0);
    float4 o1, o2;
    o1.x = (x1.x * c.x - x2.x * sn.x) * scale; o2.x = (x2.x * c.x + x1.x * sn.x) * scale;
    o1.y = (x1.y * c.y - x2.y * sn.y) * scale; o2.y = (x2.y * c.y + x1.y * sn.y) * scale;
    o1.z = (x1.z * c.z - x2.z * sn.z) * scale; o2.z = (x2.z * c.z + x1.z * sn.z) * scale;
    o1.w = (x1.w * c.w - x2.w * sn.w) * scale; o2.w = (x2.w * c.w + x1.w * sn.w) * scale;
    u16* d = dst + ((size_t)((b * H + h0 + hh) * SEQ + pos)) * 64 + j0;
    st8b(d, o1.x, o1.y, o1.z, o1.w); st8b(d + 32, o2.x, o2.y, o2.z, o2.w);
    if (do_kpart) { *reinterpret_cast<float4*>(cp) = o1; *reinterpret_cast<float4*>(cp + 32) = o2; }
  }
  if (do_kpart) {
    __syncthreads();
    const int col = tid & 127, hf = tid >> 7;
    float sm = 0.f;
    for (int r = 0; r < 64; ++r) sm += Cs[(hf * 64 + r) * CS_LD + col];
    P_kpart[((size_t)((b * 8 + h0 + (col >> 6)) * 64 + (pos0 >> 6) + hf)) * 64 + (col & 63)] = sm;
  }
}

DEV void epi_plain_hm(const float* Cs, u16* dst, int H, int h0, float scale, int b, int pos0, int tid) {
  const int pc = tid & 15, hh = pc >> 3, j0 = (pc & 7) * 8;
#pragma unroll
  for (int ps = 0; ps < 8; ++ps) {
    const int row = ps * 16 + (tid >> 4);
    float v[8]; ld8f(Cs + row * CS_LD + pc * 8, v);
#pragma unroll
    for (int e = 0; e < 8; ++e) v[e] *= scale;
    st16b(dst + ((size_t)((b * H + h0 + hh) * SEQ + pos0 + row)) * 64 + j0, v);
  }
}

DEV void epi_vt(const float* Cs, u16* dst, int H, int h0, int DH, int b, int pos0, int tid) {
  for (int idx = tid; idx < 2048; idx += 256) {
    const int quad = idx & 3, c = (idx >> 2) & 127, g = idx >> 9;
    const int h = h0 + c / DH, d = c % DH;
    float v[8];
#pragma unroll
    for (int e = 0; e < 8; ++e) { int srow = g * 32 + (e >> 2) * 16 + quad * 4 + (e & 3); v[e] = Cs[srow * CS_LD + c]; }
    st16b(dst + (((size_t)((b * H + h) * 128 + (pos0 >> 5) + g)) * DH + d) * 32 + quad * 8, v);
  }
}

DEV void epi_silu(const float* Cs, u16* dst, int col0, int tok0, int tid) {
  const int pc = tid & 15;
#pragma unroll
  for (int ps = 0; ps < 8; ++ps) {
    const int row = ps * 16 + (tid >> 4);
    float v[8]; ld8f(Cs + row * CS_LD + pc * 8, v);
#pragma unroll
    for (int e = 0; e < 8; ++e) v[e] = silu_f(v[e]);
    st16b(dst + (size_t)(tok0 + row) * 1024 + col0 + pc * 8, v);
  }
}

DEV void rope32_piece(const Params& p, const float* Cs, int row, int pos, int ch, int j0, float scale, float4& o1, float4& o2) {
  const float* cp = Cs + row * CS_LD + ch * 32 + j0;
  const float4 x1 = *reinterpret_cast<const float4*>(cp), x2 = *reinterpret_cast<const float4*>(cp + 16);
  const float4 c = *reinterpret_cast<const float4*>(P_cos32 + (size_t)pos * 16 + j0);
  const float4 sn = *reinterpret_cast<const float4*>(P_sin32 + (size_t)pos * 16 + j0);
  o1.x = (x1.x * c.x - x2.x * sn.x) * scale; o2.x = (x2.x * c.x + x1.x * sn.x) * scale;
  o1.y = (x1.y * c.y - x2.y * sn.y) * scale; o2.y = (x2.y * c.y + x1.y * sn.y) * scale;
  o1.z = (x1.z * c.z - x2.z * sn.z) * scale; o2.z = (x2.z * c.z + x1.z * sn.z) * scale;
  o1.w = (x1.w * c.w - x2.w * sn.w) * scale; o2.w = (x2.w * c.w + x1.w * sn.w) * scale;
}

DEV void epilogue_inproj(const Params& p, int layer, int nt, float* Cs, int b, int pos0, int tid) {
  const int tok0 = b * SEQ + pos0;
  const int pc = tid & 15;
  if (layer == 0) {
    if (nt < 4) epi_rope64(p, Cs, P_AQ, 8, 2 * nt, 0.125f * LOG2E, false, b, pos0, tid);
    else if (nt < 8) epi_rope64(p, Cs, P_AK, 8, 2 * (nt - 4), 1.f, true, b, pos0, tid);
    else if (nt < 12) epi_vt(Cs, P_AVt, 8, 2 * (nt - 8), 64, b, pos0, tid);
    else if (nt < 16) epi_rope64(p, Cs, P_BQ, 8, 2 * (nt - 12), 0.125f * LOG2E, false, b, pos0, tid);
    else if (nt == 16) epi_rope64(p, Cs, P_BKk, 2, 0, 1.f, false, b, pos0, tid);
    else if (nt == 17) epi_vt(Cs, P_BVt, 2, 0, 64, b, pos0, tid);
    else epi_silu(Cs, P_SG, (nt - 18) * 128, tok0, tid);
  } else {
    const float qscale = 0.10206207261596575f * LOG2E;
    if (nt < 8) {
#pragma unroll
      for (int ps = 0; ps < 8; ++ps) {
        const int row = ps * 16 + (tid >> 4);
        float v[8]; ld8f(Cs + row * CS_LD + pc * 8, v);
#pragma unroll
        for (int e = 0; e < 8; ++e) v[e] *= qscale;
        st16b(P_QC + ((size_t)(tok0 + row) * 8 + nt) * 160 + pc * 8, v);
      }
    } else if (nt < 10 || nt == 12 || nt == 13) {
      const bool isq = nt < 10;
      const int ch = pc >> 2, j0 = (pc & 3) * 4;
      const int h = 4 * (isq ? (nt - 8) : (nt - 12)) + ch;
#pragma unroll
      for (int ps = 0; ps < 8; ++ps) {
        const int row = ps * 16 + (tid >> 4);
        float4 o1, o2; rope32_piece(p, Cs, row, pos0 + row, ch, j0, isq ? qscale : 1.f, o1, o2);
        u16* d = isq ? (P_QC + ((size_t)(tok0 + row) * 8 + h) * 160 + 128 + j0) : (P_IQ + ((size_t)(tok0 + row) * 8 + h) * 32 + j0);
        st8b(d, o1.x, o1.y, o1.z, o1.w); st8b(d + 16, o2.x, o2.y, o2.z, o2.w);
      }
    } else if (nt == 10) {
      float kg[8];
      ld8f(p.kvg + pc * 8, kg);
#pragma unroll
      for (int ps = 0; ps < 8; ++ps) {
        const int row = ps * 16 + (tid >> 4);
        float v[8]; ld8f(Cs + row * CS_LD + pc * 8, v);
        float ss = 0.f;
#pragma unroll
        for (int e = 0; e < 8; ++e) ss += v[e] * v[e];
        ss += __shfl_xor(ss, 1); ss += __shfl_xor(ss, 2); ss += __shfl_xor(ss, 4); ss += __shfl_xor(ss, 8);
        const float rinv = rsqrtf(ss * (1.f / 128.f) + LN_EPS);
#pragma unroll
        for (int e = 0; e < 8; ++e) { v[e] = v[e] * rinv * kg[e]; Cs[row * CS_LD + pc * 8 + e] = v[e]; }
        st16b(P_KVC + (size_t)(tok0 + row) * 160 + pc * 8, v);
      }
      __syncthreads();
      epi_vt(Cs, P_CKVt, 1, 0, 128, b, pos0, tid);
    } else if (nt == 11) {
      const int ch = pc >> 2, j0 = (pc & 3) * 4;
#pragma unroll
      for (int ps = 0; ps < 8; ++ps) {
        const int row = ps * 16 + (tid >> 4);
        if (ch < 2) {
          float4 o1, o2; rope32_piece(p, Cs, row, pos0 + row, ch, j0, 1.f, o1, o2);
          u16* d = (ch == 0) ? (P_KVC + (size_t)(tok0 + row) * 160 + 128 + j0) : (P_IK + (size_t)(tok0 + row) * 32 + j0);
          st8b(d, o1.x, o1.y, o1.z, o1.w); st8b(d + 16, o2.x, o2.y, o2.z, o2.w);
        } else if (pc == 8 || pc == 9) {
          const float4 w = *reinterpret_cast<const float4*>(Cs + row * CS_LD + 64 + (pc - 8) * 4);
          *reinterpret_cast<float4*>(P_IW + (size_t)(tok0 + row) * 8 + (pc - 8) * 4) = w;
        }
      }
    } else if (nt < 18) epi_plain_hm(Cs, P_DQ, 8, 2 * (nt - 14), 0.125f, b, pos0, tid);
    else if (nt < 22) epi_plain_hm(Cs, P_DK, 8, 2 * (nt - 18), 1.f, b, pos0, tid);
    else if (nt < 26) epi_vt(Cs, P_DVt, 8, 2 * (nt - 22), 64, b, pos0, tid);
    else epi_silu(Cs, P_SG, (nt - 26) * 128, tok0, tid);
  }
}

DEV void phase_inproj(const Params& p, int layer, char* smem, int tid_in, int vid) {
  const int NT = layer == 0 ? 26 : 34;
  const int total = 128 * NT;
  float* Cs = reinterpret_cast<float*>(smem);
  const int G = gridDim.x;
  const int nfull = total / G, ntail = total - nfull * G;
  const int tstride = (ntail > 0 && (G % ntail) == 0) ? (G / ntail) : 1;
  const bool has_tail = (ntail > 0) && ((tstride > 1) ? ((vid % tstride) == 0) : (vid < ntail));
  const int nmine = nfull + (has_tail ? 1 : 0);
  for (int rr = 0; rr < nmine; ++rr) {
    const int it = (rr < nfull) ? (rr * G + vid) : (nfull * G + ((tstride > 1) ? (vid / tstride) : vid));
    const int tid = opq(tid_in);
    const int panel = it / (8 * NT), rem = it % (8 * NT);
    const int nt = rem >> 3, mt = panel * 8 + (rem & 7);
    const int m0 = mt * 128, n0 = nt * 128;
    const int b = m0 >> 12;
    f32x4 acc[4][4];
    gemm_mainloop<false>(P_H, layer == 0 ? P_WTe : P_WTo, m0, n0, nullptr, nullptr, nullptr, nullptr, nullptr, smem, acc, tid);
    stage_all(acc, Cs, tid);
    __syncthreads();
    epilogue_inproj(p, layer, nt, Cs, b, (m0 & 4095), tid);
    __syncthreads();
  }
}

DEV float half32_sum_at31(float v) {
  float x = v;
  x += __builtin_amdgcn_update_dpp(0.f, x, 0x111, 0xf, 0xf, false);
  x += __builtin_amdgcn_update_dpp(0.f, x, 0x112, 0xf, 0xf, false);
  x += __builtin_amdgcn_update_dpp(0.f, x, 0x114, 0xf, 0xf, false);
  x += __builtin_amdgcn_update_dpp(0.f, x, 0x118, 0xf, 0xf, false);
  const auto r = __builtin_amdgcn_permlane16_swap(__float_as_uint(x), __float_as_uint(x), false, false);
  return __uint_as_float(r[0]) + __uint_as_float(r[1]);
}
DEV void phase_outproj(const Params& p, int layer, char* smem, int tid_in, int vid) {
  float* Cs = reinterpret_cast<float*>(smem);
  float* rowstat = reinterpret_cast<float*>(smem + ROWSTAT_OFF);
  const u16* Bt = P_WOT + (size_t)layer * 1024 * 1024;
  float* stats_out = layer == 0 ? P_stats0 : P_stats1;
  for (int it = vid; it < 128 * 8; it += gridDim.x) {
    const int tid = opq(tid_in);
    const int nt = (it >> 3) & 7, mt = (it >> 6) * 8 + (it & 7);
    const int m0 = mt * 128, n0 = nt * 128;
    const int b = m0 >> 12;
    f32x4 acc[4][4];
    gemm_mainloop<false>(P_OG, Bt, m0, n0, nullptr, nullptr, nullptr, nullptr, nullptr, smem, acc, tid);
    if (layer == 1) {
      if (tid < 128) { float mu, rs; row_stats_from_partials(P_stats0, m0 + tid, mu, rs); rowstat[tid * 2] = mu; rowstat[tid * 2 + 1] = rs; }
    }
    const float* gate = P_mods + (size_t)(layer * 4 + b) * 3072 + 2048;
    stage_all(acc, Cs, tid);
    __syncthreads();
    {
      const int l32 = tid & 31, rgrp = tid >> 5;
      const int gc = n0 + l32 * 4;
      const float4 gt = *reinterpret_cast<const float4*>(gate + gc);
      float4 lg = make_float4(0.f, 0.f, 0.f, 0.f), lb = lg;
      if (layer == 1) { lg = *reinterpret_cast<const float4*>(p.ln_g + gc); lb = *reinterpret_cast<const float4*>(p.ln_b + gc); }
#pragma unroll 4
      for (int ps = 0; ps < 16; ++ps) {
        const int lrow = ps * 8 + rgrp;
        const size_t grow = (size_t)(m0 + lrow);
        float4 xr;
        if (layer == 0) xr = *reinterpret_cast<const float4*>(p.x + grow * 1024 + gc);
        else {
          const float mu = rowstat[lrow * 2], rs = rowstat[lrow * 2 + 1];
          const float4 v0 = *reinterpret_cast<const float4*>(p.out + grow * 1024 + gc);
          xr.x = (v0.x - mu) * rs * lg.x + lb.x; xr.y = (v0.y - mu) * rs * lg.y + lb.y;
          xr.z = (v0.z - mu) * rs * lg.z + lb.z; xr.w = (v0.w - mu) * rs * lg.w + lb.w;
        }
        const float4 y = *reinterpret_cast<const float4*>(Cs + lrow * CS_LD + l32 * 4);
        float4 v;
        v.x = DN_ALPHA * xr.x + (1.f + gt.x) * y.x; v.y = DN_ALPHA * xr.y + (1.f + gt.y) * y.y;
        v.z = DN_ALPHA * xr.z + (1.f + gt.z) * y.z; v.w = DN_ALPHA * xr.w + (1.f + gt.w) * y.w;
        float sm = v.x + v.y + v.z + v.w, ss = v.x * v.x + v.y * v.y + v.z * v.z + v.w * v.w;
        *reinterpret_cast<float4*>(p.out + grow * 1024 + gc) = v;
        sm = half32_sum_at31(sm); ss = half32_sum_at31(ss);
        if (l32 == 31) { stats_out[grow * 16 + nt * 2] = sm; stats_out[grow * 16 + nt * 2 + 1] = ss; }
      }
    }
    __syncthreads();
  }
}

DEV void phase_prep(const Params& p, int layer, int tid) {
  const int lane = tid & 63;
  const int gw = blockIdx.x * 4 + (tid >> 6), nw = gridDim.x * 4;
  for (int row = gw; row < NTOK; row += nw) {
    const int b = row >> 12;
    const float* modb = P_mods + (size_t)(layer * 4 + b) * 3072;
    const float* src = (layer == 0 ? p.x : p.out) + (size_t)row * 1024;
    float mu = 0.f, rs = 1.f;
    if (layer == 1) row_stats_from_partials(P_stats0, row, mu, rs);
    u16* dst = P_H + (size_t)row * 1024;
#pragma unroll
    for (int i = 0; i < 4; ++i) {
      const int c = i * 256 + lane * 4;
      float4 v = *reinterpret_cast<const float4*>(src + c);
      if (layer == 1) {
        const float4 g = *reinterpret_cast<const float4*>(p.ln_g + c);
        const float4 bb = *reinterpret_cast<const float4*>(p.ln_b + c);
        v.x = (v.x - mu) * rs * g.x + bb.x; v.y = (v.y - mu) * rs * g.y + bb.y;
        v.z = (v.z - mu) * rs * g.z + bb.z; v.w = (v.w - mu) * rs * g.w + bb.w;
      }
      const float4 sh = *reinterpret_cast<const float4*>(modb + c);
      const float4 sc = *reinterpret_cast<const float4*>(modb + 1024 + c);
      st8b(dst + c, v.x * (1.f + sc.x) + sh.x, v.y * (1.f + sc.y) + sh.y, v.z * (1.f + sc.z) + sh.z, v.w * (1.f + sc.w) + sh.w);
    }
  }
}

DEV void phase_final_ln(const Params& p, int tid) {
  const int lane = tid & 63;
  const int gw = blockIdx.x * 4 + (tid >> 6), nw = gridDim.x * 4;
  const float* g = p.ln_g + 1024; const float* bb = p.ln_b + 1024;
  for (int row = gw; row < NTOK; row += nw) {
    float mu, rs; row_stats_from_partials(P_stats1, row, mu, rs);
    float* rp = p.out + (size_t)row * 1024;
#pragma unroll
    for (int i = 0; i < 4; ++i) {
      const int c = i * 256 + lane * 4;
      float4 v = *reinterpret_cast<const float4*>(rp + c);
      float4 gg = *reinterpret_cast<const float4*>(g + c);
      float4 b4 = *reinterpret_cast<const float4*>(bb + c);
      v.x = (v.x - mu) * rs * gg.x + b4.x; v.y = (v.y - mu) * rs * gg.y + b4.y;
      v.z = (v.z - mu) * rs * gg.z + b4.z; v.w = (v.w - mu) * rs * gg.w + b4.w;
      *reinterpret_cast<float4*>(rp + c) = v;
    }
  }
}

DEV float xq_max(float x) {
  unsigned u = __float_as_uint(x);
  auto r = __builtin_amdgcn_permlane32_swap(u, u, false, false);
  const float m = fmaxf(__uint_as_float(r[0]), __uint_as_float(r[1]));
  unsigned v = __float_as_uint(m);
  auto s2 = __builtin_amdgcn_permlane16_swap(v, v, false, false);
  return fmaxf(__uint_as_float(s2[0]), __uint_as_float(s2[1]));
}
DEV float xq_sum(float x) {
  unsigned u = __float_as_uint(x);
  auto r = __builtin_amdgcn_permlane32_swap(u, u, false, false);
  const float m = __uint_as_float(r[0]) + __uint_as_float(r[1]);
  unsigned v = __float_as_uint(m);
  auto s2 = __builtin_amdgcn_permlane16_swap(v, v, false, false);
  return __uint_as_float(s2[0]) + __uint_as_float(s2[1]);
}
template <int NKS, int NDT, class MaskF>
DEV void flash_chunk(const u16* __restrict__ Kc, int ldk, const u16* __restrict__ Vc, const bf16x8 (&qf)[2][NKS],
                     float (&m)[2], float (&l)[2], f32x4 (&o)[NDT][2], int lane, MaskF mask) {
  const int lr = lane & 15, quad = lane >> 4;
  f32x4 st[4][2];
#pragma unroll
  for (int kt = 0; kt < 4; ++kt) { st[kt][0] = f32x4{0.f, 0.f, 0.f, 0.f}; st[kt][1] = f32x4{0.f, 0.f, 0.f, 0.f}; }
#pragma unroll
  for (int kt = 0; kt < 4; ++kt)
#pragma unroll
    for (int ks = 0; ks < NKS; ++ks) {
      bf16x8 kf = ld8(Kc + (size_t)(kt * 16 + lr) * ldk + ks * 32 + quad * 8);
      st[kt][0] = mfma16(kf, qf[0][ks], st[kt][0]);
      st[kt][1] = mfma16(kf, qf[1][ks], st[kt][1]);
    }
#pragma unroll
  for (int c = 0; c < 2; ++c) {
    float cm = NEG_INF;
#pragma unroll
    for (int kt = 0; kt < 4; ++kt)
#pragma unroll
      for (int j = 0; j < 4; ++j) { float s = mask(kt, j, c) ? st[kt][c][j] : NEG_INF; st[kt][c][j] = s; cm = fmaxf(cm, s); }
    cm = xq_max(cm);
    const float mn = fmaxf(m[c], cm);
    const float ms = (mn == NEG_INF) ? 0.f : mn;
    const float alpha = fexp2(m[c] - ms);
    m[c] = mn;
    float ps = 0.f;
#pragma unroll
    for (int kt = 0; kt < 4; ++kt)
#pragma unroll
      for (int j = 0; j < 4; ++j) { float pv = fexp2(st[kt][c][j] - ms); st[kt][c][j] = pv; ps += pv; }
    l[c] = l[c] * alpha + ps;
#pragma unroll
    for (int dt = 0; dt < NDT; ++dt) { o[dt][c][0] *= alpha; o[dt][c][1] *= alpha; o[dt][c][2] *= alpha; o[dt][c][3] *= alpha; }
  }
  bf16x8 pb[2][2];
#pragma unroll
  for (int c = 0; c < 2; ++c)
#pragma unroll
    for (int g = 0; g < 2; ++g)
      pb[c][g] = pack8(st[2 * g][c][0], st[2 * g][c][1], st[2 * g][c][2], st[2 * g][c][3],
                       st[2 * g + 1][c][0], st[2 * g + 1][c][1], st[2 * g + 1][c][2], st[2 * g + 1][c][3]);
#pragma unroll
  for (int g = 0; g < 2; ++g)
#pragma unroll
    for (int dt = 0; dt < NDT; ++dt) {
      bf16x8 vf = ld8(Vc + ((size_t)((g * NDT + dt) * 16 + lr) * 4 + quad) * 8);
      o[dt][0] = mfma16(vf, pb[0][g], o[dt][0]);
      o[dt][1] = mfma16(vf, pb[1][g], o[dt][1]);
    }
}

DEV void load_kv64(const u16* __restrict__ Kc, const u16* __restrict__ Vc, bf16x8 (&kf)[4][2], bf16x8 (&vf)[2][4], int lane) {
  const int lr = lane & 15, quad = lane >> 4;
#pragma unroll
  for (int kt = 0; kt < 4; ++kt)
#pragma unroll
    for (int ks = 0; ks < 2; ++ks) kf[kt][ks] = ld8(Kc + (size_t)(kt * 16 + lr) * 64 + ks * 32 + quad * 8);
#pragma unroll
  for (int g = 0; g < 2; ++g)
#pragma unroll
    for (int dt = 0; dt < 4; ++dt) vf[g][dt] = ld8(Vc + ((size_t)((g * 4 + dt) * 16 + lr) * 4 + quad) * 8);
}
DEV void copy_kv64(bf16x8 (&kd)[4][2], bf16x8 (&vd)[2][4], const bf16x8 (&ks_)[4][2], const bf16x8 (&vs)[2][4]) {
#pragma unroll
  for (int a = 0; a < 4; ++a) { kd[a][0] = ks_[a][0]; kd[a][1] = ks_[a][1]; }
#pragma unroll
  for (int g = 0; g < 2; ++g)
#pragma unroll
    for (int dt = 0; dt < 4; ++dt) vd[g][dt] = vs[g][dt];
}
template <class MaskF>
DEV void flash_chunk_pre(const bf16x8 (&kf)[4][2], const bf16x8 (&vf)[2][4], const bf16x8 (&qf)[2][2],
                         float (&m)[2], float (&l)[2], f32x4 (&o)[4][2], int lane, MaskF mask) {
  f32x4 st[4][2];
#pragma unroll
  for (int kt = 0; kt < 4; ++kt) {
    st[kt][0] = f32x4{0.f, 0.f, 0.f, 0.f}; st[kt][1] = f32x4{0.f, 0.f, 0.f, 0.f};
#pragma unroll
    for (int ks = 0; ks < 2; ++ks) { st[kt][0] = mfma16(kf[kt][ks], qf[0][ks], st[kt][0]); st[kt][1] = mfma16(kf[kt][ks], qf[1][ks], st[kt][1]); }
  }
#pragma unroll
  for (int c = 0; c < 2; ++c) {
    float cm = NEG_INF;
#pragma unroll
    for (int kt = 0; kt < 4; ++kt)
#pragma unroll
      for (int j = 0; j < 4; ++j) { float sv = mask(kt, j, c) ? st[kt][c][j] : NEG_INF; st[kt][c][j] = sv; cm = fmaxf(cm, sv); }
    cm = xq_max(cm);
    if (!__all(cm <= m[c] + 8.f)) {
      const float mn = fmaxf(m[c], cm);
      const float msn = (mn == NEG_INF) ? 0.f : mn;
      const float alpha = fexp2(m[c] - msn);
      m[c] = mn;
      l[c] *= alpha;
#pragma unroll
      for (int dt = 0; dt < 4; ++dt) { o[dt][c][0] *= alpha; o[dt][c][1] *= alpha; o[dt][c][2] *= alpha; o[dt][c][3] *= alpha; }
    }
    const float ms = (m[c] == NEG_INF) ? 0.f : m[c];
    float ps = 0.f;
#pragma unroll
    for (int kt = 0; kt < 4; ++kt)
#pragma unroll
      for (int j = 0; j < 4; ++j) { float pv = fexp2(st[kt][c][j] - ms); st[kt][c][j] = pv; ps += pv; }
    l[c] += ps;
  }
#pragma unroll
  for (int g = 0; g < 2; ++g) {
    const bf16x8 p0 = pack8(st[2 * g][0][0], st[2 * g][0][1], st[2 * g][0][2], st[2 * g][0][3], st[2 * g + 1][0][0], st[2 * g + 1][0][1], st[2 * g + 1][0][2], st[2 * g + 1][0][3]);
    const bf16x8 p1 = pack8(st[2 * g][1][0], st[2 * g][1][1], st[2 * g][1][2], st[2 * g][1][3], st[2 * g + 1][1][0], st[2 * g + 1][1][1], st[2 * g + 1][1][2], st[2 * g + 1][1][3]);
#pragma unroll
    for (int dt = 0; dt < 4; ++dt) { o[dt][0] = mfma16(vf[g][dt], p0, o[dt][0]); o[dt][1] = mfma16(vf[g][dt], p1, o[dt][1]); }
  }
}

DEV void write_og4(const Params& p, f32x4 (&o)[4][2], const float (&inv)[2], int b, int tq0, int colbase, int lane) {
  const int lr = lane & 15, quad = lane >> 4;
#pragma unroll
  for (int c = 0; c < 2; ++c) {
    const size_t base = ((size_t)(b * SEQ + tq0 + c * 16 + lr)) * 1024 + colbase + quad * 4;
#pragma unroll
    for (int dt = 0; dt < 4; ++dt) {
      uint2 sg = *reinterpret_cast<const uint2*>(P_SG + base + dt * 16);
      float g0 = bf2f((u16)(sg.x & 0xFFFF)), g1 = bf2f((u16)(sg.x >> 16)), g2 = bf2f((u16)(sg.y & 0xFFFF)), g3 = bf2f((u16)(sg.y >> 16));
      st8b(P_OG + base + dt * 16, o[dt][c][0] * inv[c] * g0, o[dt][c][1] * inv[c] * g1, o[dt][c][2] * inv[c] * g2, o[dt][c][3] * inv[c] * g3);
    }
  }
}

DEV float quad_sum(float v) { return xq_sum(v); }

DEV void moba_item(const Params& p, int b, int h, int qt, int wave, int lane, char* smem) {
  const int lr = lane & 15, quad = lane >> 4;
  const int q0 = qt * 128 + wave * 32;
  const int own = q0 >> 8;
  const size_t hb = (size_t)(b * 8 + h) * SEQ * 64;
  const u16* Q = P_AQ + hb; const u16* K = P_AK + hb; const u16* Vt = P_AVt + hb;
  bf16x8 qf[2][2];
#pragma unroll
  for (int c = 0; c < 2; ++c)
#pragma unroll
    for (int ks = 0; ks < 2; ++ks) qf[c][ks] = ld8(Q + (size_t)(q0 + c * 16 + lr) * 64 + ks * 32 + quad * 8);
  unsigned selmask[2] = {0u, 0u};
  if (own > 0) {
    bf16x8 kmf[2];
#pragma unroll
    for (int ks = 0; ks < 2; ++ks) {
      float s[8];
#pragma unroll
      for (int e = 0; e < 8; ++e) s[e] = 0.f;
      if (lr < own) {
#pragma unroll
        for (int part = 0; part < 4; ++part) {
          const float* kp = P_kpart + ((size_t)((b * 8 + h) * 64 + lr * 4 + part)) * 64 + ks * 32 + quad * 8;
          float4 a = *reinterpret_cast<const float4*>(kp); float4 bq = *reinterpret_cast<const float4*>(kp + 4);
          s[0] += a.x; s[1] += a.y; s[2] += a.z; s[3] += a.w; s[4] += bq.x; s[5] += bq.y; s[6] += bq.z; s[7] += bq.w;
        }
      }
      const float r = 1.f / 256.f;
      kmf[ks] = pack8(s[0] * r, s[1] * r, s[2] * r, s[3] * r, s[4] * r, s[5] * r, s[6] * r, s[7] * r);
    }
#pragma unroll
    for (int c = 0; c < 2; ++c) {
      f32x4 g = f32x4{0.f, 0.f, 0.f, 0.f};
      g = mfma16(kmf[0], qf[c][0], g); g = mfma16(kmf[1], qf[c][1], g);
      float v[4];
#pragma unroll
      for (int j = 0; j < 4; ++j) v[j] = (quad * 4 + j < own) ? g[j] : NEG_INF;
      unsigned sm = 0u;
#pragma unroll
      for (int itr = 0; itr < 3; ++itr) {
        float best = NEG_INF; int bi = 99;
#pragma unroll
        for (int j = 0; j < 4; ++j) if (v[j] > best) { best = v[j]; bi = quad * 4 + j; }
#pragma unroll
        for (int off = 16; off <= 32; off <<= 1) {
          float ob = __shfl_xor(best, off); int oi = __shfl_xor(bi, off);
          if (ob > best || (ob == best && oi < bi)) { best = ob; bi = oi; }
        }
        if (bi < 16) {
          sm |= 1u << bi;
#pragma unroll
          for (int j = 0; j < 4; ++j) if (quad * 4 + j == bi) v[j] = NEG_INF;
        }
      }
      selmask[c] = sm;
    }
  }
  float m[2] = {NEG_INF, NEG_INF}, l[2] = {0.f, 0.f};
  f32x4 o[4][2];
#pragma unroll
  for (int dt = 0; dt < 4; ++dt) { o[dt][0] = f32x4{0.f, 0.f, 0.f, 0.f}; o[dt][1] = f32x4{0.f, 0.f, 0.f, 0.f}; }
  {
    const int tid = wave * 64 + lane;
    const int cend_w = (q0 + 31) >> 6;
    const int cend_b = (qt * 128 + 127) >> 6;
    uint4 r0, r1, r2, r3;
    const int kid0 = tid, kid1 = tid + 256;
    const int krow0 = kid0 >> 3, kc0 = kid0 & 7, krow1 = kid1 >> 3, kc1 = kid1 & 7;
    const int kst0 = krow0 * 128 + ((kc0 ^ ((krow0 >> 1) & 7)) << 4), kst1 = krow1 * 128 + ((kc1 ^ ((krow1 >> 1) & 7)) << 4);
    const int vlr0 = (kid0 >> 2) & 15, vq0 = kid0 & 3, vlr1 = (kid1 >> 2) & 15, vq1 = kid1 & 3;
    const int vst0 = 8192 + (kid0 >> 6) * 1024 + vlr0 * 64 + ((vq0 ^ (vlr0 >= 8 ? 3 : 0)) << 4);
    const int vst1 = 8192 + (kid1 >> 6) * 1024 + vlr1 * 64 + ((vq1 ^ (vlr1 >= 8 ? 3 : 0)) << 4);
#define MOBA_LOAD(CH) do { const u16* kg_ = K + (size_t)(CH) * 64 * 64; const u16* vg_ = Vt + (size_t)(CH) * 2 * 64 * 32; \
      r0 = *reinterpret_cast<const uint4*>(kg_ + kid0 * 8); r1 = *reinterpret_cast<const uint4*>(kg_ + kid1 * 8); \
      r2 = *reinterpret_cast<const uint4*>(vg_ + kid0 * 8); r3 = *reinterpret_cast<const uint4*>(vg_ + kid1 * 8); } while (0)
#define MOBA_STORE(STG) do { char* sb_ = smem + (STG) * 16384; \
      *reinterpret_cast<uint4*>(sb_ + kst0) = r0; *reinterpret_cast<uint4*>(sb_ + kst1) = r1; \
      *reinterpret_cast<uint4*>(sb_ + vst0) = r2; *reinterpret_cast<uint4*>(sb_ + vst1) = r3; } while (0)
    const int kro = lr * 128, ksw = (lr >> 1) & 7;
    const int vro = 8192 + lr * 64 + ((quad ^ (lr >= 8 ? 3 : 0)) << 4);
    MOBA_LOAD(0);
    MOBA_STORE(0);
    if (cend_b >= 1) MOBA_LOAD(1);
    __syncthreads();
    for (int chk = 0; chk <= cend_b; ++chk) {
      if (chk + 1 <= cend_b) MOBA_STORE((chk + 1) & 1);
      if (chk + 2 <= cend_b) MOBA_LOAD(chk + 2);
      const int cb = chk * 64, n = chk >> 2;
      const bool past = n < own;
      const bool s0 = (selmask[0] >> n) & 1u, s1 = (selmask[1] >> n) & 1u;
      if (chk <= cend_w && (!past || __ballot(s0 || s1) != 0ull)) {
        const char* sb = smem + (chk & 1) * 16384;
        bf16x8 kc[4][2], vc[2][4];
#pragma unroll
        for (int kt = 0; kt < 4; ++kt)
#pragma unroll
          for (int ks = 0; ks < 2; ++ks) kc[kt][ks] = *reinterpret_cast<const bf16x8*>(sb + kt * 2048 + kro + (((ks * 4 + quad) ^ ksw) << 4));
#pragma unroll
        for (int g = 0; g < 2; ++g)
#pragma unroll
          for (int dt = 0; dt < 4; ++dt) vc[g][dt] = *reinterpret_cast<const bf16x8*>(sb + (g * 4 + dt) * 1024 + vro);
        flash_chunk_pre(kc, vc, qf, m, l, o, lane,
                        [&](int kt, int j, int c) { return past ? (c ? s1 : s0) : ((cb + kt * 16 + quad * 4 + j) <= (q0 + c * 16 + lr)); });
      }
      __syncthreads();
    }
  }
  float inv[2];
  inv[0] = 1.f / quad_sum(l[0]); inv[1] = 1.f / quad_sum(l[1]);
  write_og4(p, o, inv, b, q0, h * 64, lane);
}

DEV void swa_item(const Params& p, int b, int kvh, int t32, int wave, int lane, char* smem) {
  const int lr = lane & 15, quad = lane >> 4;
  const int q0 = t32 * 32;
  const int qh = kvh * 4 + wave;
  const u16* Q = P_BQ + (size_t)(b * 8 + qh) * SEQ * 64;
  const u16* K = P_BKk + (size_t)(b * 2 + kvh) * SEQ * 64;
  const u16* Vt = P_BVt + (size_t)(b * 2 + kvh) * SEQ * 64;
  bf16x8 qf[2][2];
#pragma unroll
  for (int c = 0; c < 2; ++c)
#pragma unroll
    for (int ks = 0; ks < 2; ++ks) qf[c][ks] = ld8(Q + (size_t)(q0 + c * 16 + lr) * 64 + ks * 32 + quad * 8);
  float m[2] = {NEG_INF, NEG_INF}, l[2] = {0.f, 0.f};
  f32x4 o[4][2];
#pragma unroll
  for (int dt = 0; dt < 4; ++dt) { o[dt][0] = f32x4{0.f, 0.f, 0.f, 0.f}; o[dt][1] = f32x4{0.f, 0.f, 0.f, 0.f}; }
  {
    const int tid = wave * 64 + lane;
    const int lo = (q0 - 127) > 0 ? (q0 - 127) : 0;
    const int c0 = lo >> 6, c1 = (q0 + 31) >> 6;
    uint4 r0, r1, r2, r3;
    const int kid0 = tid, kid1 = tid + 256;
    const int krow0 = kid0 >> 3, kc0 = kid0 & 7, krow1 = kid1 >> 3, kc1 = kid1 & 7;
    const int kst0 = krow0 * 128 + ((kc0 ^ ((krow0 >> 1) & 7)) << 4), kst1 = krow1 * 128 + ((kc1 ^ ((krow1 >> 1) & 7)) << 4);
    const int vlr0 = (kid0 >> 2) & 15, vq0 = kid0 & 3, vlr1 = (kid1 >> 2) & 15, vq1 = kid1 & 3;
    const int vst0 = 8192 + (kid0 >> 6) * 1024 + vlr0 * 64 + ((vq0 ^ (vlr0 >= 8 ? 3 : 0)) << 4);
    const int vst1 = 8192 + (kid1 >> 6) * 1024 + vlr1 * 64 + ((vq1 ^ (vlr1 >= 8 ? 3 : 0)) << 4);
    const int kro = lr * 128, ksw = (lr >> 1) & 7;
    const int vro = 8192 + lr * 64 + ((quad ^ (lr >= 8 ? 3 : 0)) << 4);
    MOBA_LOAD(c0);
    MOBA_STORE(0);
    if (c0 + 1 <= c1) MOBA_LOAD(c0 + 1);
    __syncthreads();
    for (int chk = c0; chk <= c1; ++chk) {
      const int stg = (chk - c0) & 1;
      if (chk + 1 <= c1) MOBA_STORE(stg ^ 1);
      if (chk + 2 <= c1) MOBA_LOAD(chk + 2);
      const int cb = chk * 64;
      {
        const char* sb = smem + stg * 16384;
        bf16x8 kc[4][2], vc[2][4];
#pragma unroll
        for (int kt = 0; kt < 4; ++kt)
#pragma unroll
          for (int ks = 0; ks < 2; ++ks) kc[kt][ks] = *reinterpret_cast<const bf16x8*>(sb + kt * 2048 + kro + (((ks * 4 + quad) ^ ksw) << 4));
#pragma unroll
        for (int g = 0; g < 2; ++g)
#pragma unroll
          for (int dt = 0; dt < 4; ++dt) vc[g][dt] = *reinterpret_cast<const bf16x8*>(sb + (g * 4 + dt) * 1024 + vro);
        flash_chunk_pre(kc, vc, qf, m, l, o, lane,
                        [&](int kt, int j, int c) { int key = cb + kt * 16 + quad * 4 + j; int t = q0 + c * 16 + lr; return key <= t && key > t - 128; });
      }
      __syncthreads();
    }
  }
  const float sl = p.sinks[qh] * LOG2E;
  float inv[2];
#pragma unroll
  for (int c = 0; c < 2; ++c) {
    float lt = quad_sum(l[c]);
    float mf = fmaxf(m[c], sl);
    float a = fexp2(m[c] - mf);
    inv[c] = a / (lt * a + fexp2(sl - mf));
  }
  write_og4(p, o, inv, b, q0, 512 + qh * 64, lane);
}

DEV void sb_item(const Params& p, int b, int h, int qt, int wave, int lane) {
  const int lr = lane & 15, quad = lane >> 4;
  const int q0 = qt * 128 + wave * 32;
  const size_t hb = (size_t)(b * 8 + h) * SEQ * 64;
  const u16* Q = P_DQ + hb; const u16* K = P_DK + hb; const u16* Vt = P_DVt + hb;
  bf16x8 qf[2][2];
#pragma unroll
  for (int c = 0; c < 2; ++c)
#pragma unroll
    for (int ks = 0; ks < 2; ++ks) qf[c][ks] = ld8(Q + (size_t)(q0 + c * 16 + lr) * 64 + ks * 32 + quad * 8);
  float carry[2] = {0.f, 0.f};
  f32x4 o[4][2];
#pragma unroll
  for (int dt = 0; dt < 4; ++dt) { o[dt][0] = f32x4{0.f, 0.f, 0.f, 0.f}; o[dt][1] = f32x4{0.f, 0.f, 0.f, 0.f}; }
  bf16x8 kc[4][2], kn[4][2], vc[2][4];
  {
    const u16* Kc0 = K + (size_t)((q0 + 31) >> 6) * 64 * 64;
#pragma unroll
    for (int kt = 0; kt < 4; ++kt)
#pragma unroll
      for (int ks = 0; ks < 2; ++ks) kc[kt][ks] = ld8(Kc0 + (size_t)(kt * 16 + lr) * 64 + ks * 32 + quad * 8);
  }
  for (int chk = (q0 + 31) >> 6; chk >= 0; --chk) {
    const int cb = chk * 64;
    {
      const u16* Vc = Vt + (size_t)chk * 2 * 64 * 32;
#pragma unroll
      for (int g = 0; g < 2; ++g)
#pragma unroll
        for (int dt = 0; dt < 4; ++dt) vc[g][dt] = ld8(Vc + ((size_t)((g * 4 + dt) * 16 + lr) * 4 + quad) * 8);
    }
    if (chk > 0) {
      const u16* Kn = K + (size_t)(chk - 1) * 64 * 64;
#pragma unroll
      for (int kt = 0; kt < 4; ++kt)
#pragma unroll
        for (int ks = 0; ks < 2; ++ks) kn[kt][ks] = ld8(Kn + (size_t)(kt * 16 + lr) * 64 + ks * 32 + quad * 8);
    }
    f32x4 st[4][2];
#pragma unroll
    for (int kt = 0; kt < 4; ++kt) {
      st[kt][0] = f32x4{0.f, 0.f, 0.f, 0.f}; st[kt][1] = f32x4{0.f, 0.f, 0.f, 0.f};
#pragma unroll
      for (int ks = 0; ks < 2; ++ks) { st[kt][0] = mfma16(kc[kt][ks], qf[0][ks], st[kt][0]); st[kt][1] = mfma16(kc[kt][ks], qf[1][ks], st[kt][1]); }
    }
#pragma unroll
    for (int c = 0; c < 2; ++c) {
      const int t = q0 + c * 16 + lr;
      float lk[4][4], hq[4], tot[4];
#pragma unroll
      for (int kt = 0; kt < 4; ++kt) {
        float g = 0.f;
#pragma unroll
        for (int j = 0; j < 4; ++j) {
          const int key = cb + kt * 16 + quad * 4 + j;
          const float z = st[kt][c][j];
          const float sp = fmaxf(z, 0.f) + flog(1.f + fexp(-fabsf(z)));
          const float v = (key < t) ? -sp : 0.f;
          lk[kt][j] = v; g += v;
        }
        const auto r16 = __builtin_amdgcn_permlane16_swap(__float_as_uint(g), __float_as_uint(g), false, false);
        const float od = __uint_as_float(r16[1]);
        const float psum = __uint_as_float(r16[0]) + od;
        const auto r32 = __builtin_amdgcn_permlane32_swap(__float_as_uint(psum), __float_as_uint(psum), false, false);
        const float p01 = __uint_as_float(r32[0]), p23 = __uint_as_float(r32[1]);
        hq[kt] = (quad == 0) ? (od + p23) : (quad == 1) ? p23 : (quad == 2) ? od : 0.f;
        tot[kt] = p01 + p23;
      }
      float run = carry[c];
#pragma unroll
      for (int kt = 3; kt >= 0; --kt) {
        const float base = run + hq[kt];
        float ex = 0.f;
#pragma unroll
        for (int j = 3; j >= 0; --j) {
          const int key = cb + kt * 16 + quad * 4 + j;
          const float z = st[kt][c][j];
          const float a = (key < t) ? fexp(z + lk[kt][j] + base + ex) : 0.f;
          st[kt][c][j] = a;
          ex += lk[kt][j];
        }
        run += tot[kt];
      }
      carry[c] = run;
    }
    bf16x8 pb[2][2];
#pragma unroll
    for (int c = 0; c < 2; ++c)
#pragma unroll
      for (int g = 0; g < 2; ++g)
        pb[c][g] = pack8(st[2 * g][c][0], st[2 * g][c][1], st[2 * g][c][2], st[2 * g][c][3],
                         st[2 * g + 1][c][0], st[2 * g + 1][c][1], st[2 * g + 1][c][2], st[2 * g + 1][c][3]);
#pragma unroll
    for (int g = 0; g < 2; ++g)
#pragma unroll
      for (int dt = 0; dt < 4; ++dt) {
        o[dt][0] = mfma16(vc[g][dt], pb[0][g], o[dt][0]);
        o[dt][1] = mfma16(vc[g][dt], pb[1][g], o[dt][1]);
      }
#pragma unroll
    for (int kt = 0; kt < 4; ++kt) { kc[kt][0] = kn[kt][0]; kc[kt][1] = kn[kt][1]; }
    if (__all((carry[0] < -104.f) && (carry[1] < -104.f))) break;
  }
  const float inv[2] = {1.f, 1.f};
  write_og4(p, o, inv, b, q0, 512 + h * 64, lane);
}

DEV int wave_sum_dpp(int v) {
  int x = v;
  x += __builtin_amdgcn_update_dpp(0, x, 0x111, 0xf, 0xf, false);
  x += __builtin_amdgcn_update_dpp(0, x, 0x112, 0xf, 0xf, false);
  x += __builtin_amdgcn_update_dpp(0, x, 0x114, 0xf, 0xf, false);
  x += __builtin_amdgcn_update_dpp(0, x, 0x118, 0xf, 0xf, false);
  x += __builtin_amdgcn_update_dpp(0, x, 0x142, 0xa, 0xf, false);
  x += __builtin_amdgcn_update_dpp(0, x, 0x143, 0xc, 0xf, false);
  return __builtin_amdgcn_readlane(x, 63);
}
DEV u16 key16(float s) { u16 u = f2bf(s); return (u & 0x8000u) ? (u16)(~u) : (u16)(u | 0x8000u); }

DEV void dsa_item(const Params& p, int b, int tile16, char* smem, int tid) {
  u16* keys = reinterpret_cast<u16*>(smem);
  u64* maskL = reinterpret_cast<u64*>(smem + 65536);
  const int wave = tid >> 6, lane = tid & 63, lr = lane & 15, quad = lane >> 4;
  const int t0 = tile16 * 16;
  const int nch = ((t0 + 15) >> 6) + 1;
  const size_t tb = (size_t)b * SEQ;
#if DBL == 10
  for (int half2 = 0; half2 < 4; ++half2) {
    const int half = half2 & 1;
#elif DBL == 12
  for (int half2 = 0; half2 < 2; ++half2) {
    const int half = half2;
#else
  for (int half = 0; half < 2; ++half) {
#endif
    const int qh0 = t0 + half * 8;
#if DBL == 12
    for (int rep = 0; rep < 2; ++rep)
#endif
    {
      bf16x8 ax[2], ay[2]; float wx[2][4], wy[2][4];
#pragma unroll
      for (int pr = 0; pr < 2; ++pr) {
        const int q = qh0 + pr * 4 + (lr >> 2);
        ax[pr] = ld8(P_IQ + ((tb + q) * 8 + (lr & 3)) * 32 + quad * 8);
        ay[pr] = ld8(P_IQ + ((tb + q) * 8 + 4 + (lr & 3)) * 32 + quad * 8);
        const int qo = qh0 + pr * 4 + quad;
        const float4 w0 = *reinterpret_cast<const float4*>(P_IW + (tb + qo) * 8);
        const float4 w1 = *reinterpret_cast<const float4*>(P_IW + (tb + qo) * 8 + 4);
        wx[pr][0] = w0.x; wx[pr][1] = w0.y; wx[pr][2] = w0.z; wx[pr][3] = w0.w;
        wy[pr][0] = w1.x; wy[pr][1] = w1.y; wy[pr][2] = w1.z; wy[pr][3] = w1.w;
      }
      for (int tile = wave; tile < ((nch + 1) >> 1) * 8; tile += 4) {
        const int key = tile * 16 + lr;
        const bf16x8 kf = ld8(P_IK + (tb + key) * 32 + quad * 8);
#pragma unroll
        for (int pr = 0; pr < 2; ++pr) {
          f32x4 X = mfma16(ax[pr], kf, f32x4{0.f, 0.f, 0.f, 0.f});
          f32x4 Y = mfma16(ay[pr], kf, f32x4{0.f, 0.f, 0.f, 0.f});
          float sc = 0.f;
#pragma unroll
          for (int j = 0; j < 4; ++j) { sc = fmaf(fmaxf(X[j], 0.f), wx[pr][j], sc); sc = fmaf(fmaxf(Y[j], 0.f), wy[pr][j], sc); }
          const int qo = qh0 + pr * 4 + quad;
          keys[(pr * 4 + quad) * 4096 + (key & ~127) + ((key & 63) << 1) + ((key >> 6) & 1)] = (key <= qo) ? key16(sc) : (u16)0;
        }
      }
    }
    __syncthreads();
    {
      const int qiA = wave * 2, qiB = wave * 2 + 1;
      const unsigned* kpA = reinterpret_cast<const unsigned*>(keys + qiA * 4096) + lane;
      const unsigned* kpB = reinterpret_cast<const unsigned*>(keys + qiB * 4096) + lane;
      const int nrd = (nch + 1) >> 1;
      unsigned TA = 0u, TB = 0u;
      for (int bit = 15; bit >= 0; --bit) {
        const unsigned cA = TA | (1u << bit), cB = TB | (1u << bit);
        int nA = 0, nB = 0;
#pragma unroll 4
        for (int r = 0; r < nrd; ++r) {
          const unsigned ka = kpA[r * 64], kb = kpB[r * 64];
          nA += ((ka & 0xFFFFu) >= cA) + ((ka >> 16) >= cA);
          nB += ((kb & 0xFFFFu) >= cB) + ((kb >> 16) >= cB);
        }
        const int pk = wave_sum_dpp(nA | (nB << 16));
        if ((pk & 0xFFFF) >= 256) TA = cA;
        if ((pk >> 16) >= 256) TB = cB;
      }
#pragma unroll
      for (int qq = 0; qq < 2; ++qq) {
        const unsigned T = qq ? TB : TA;
        const unsigned* kp = qq ? kpB : kpA;
        const int qi = wave * 2 + qq;
        int gl = 0;
#pragma unroll 4
        for (int r = 0; r < nrd; ++r) { const unsigned kv = kp[r * 64]; gl += ((kv & 0xFFFFu) > T) + ((kv >> 16) > T); }
        gl = wave_sum_dpp(gl);
        const int need = (T > 0u) ? (256 - gl) : 0;
        int running = 0;
        const u64 lt_mask = (lane == 0) ? 0ull : (~0ull >> (64 - lane));
        for (int r = 0; r < nrd; ++r) {
          const unsigned kv = kp[r * 64];
#pragma unroll
          for (int hf = 0; hf < 2; ++hf) {
            const unsigned kk = hf ? (kv >> 16) : (kv & 0xFFFFu);
            const bool eq = (T > 0u) && (kk == T);
            const u64 beq = __ballot(eq);
            const int rank = running + __popcll(beq & lt_mask);
            const bool sel = (kk > T) || (eq && rank < need);
            const u64 msk = __ballot(sel);
            running += __popcll(beq);
            if (lane == 0) maskL[(half * 8 + qi) * 64 + r * 2 + hf] = msk;
          }
        }
      }
    }
    __syncthreads();
  }
  {
    char* gbuf = smem + wave * 10752;
    u16* idxL = reinterpret_cast<u16*>(smem + 43008 + wave * 1088);
    unsigned char* flL = reinterpret_cast<unsigned char*>(smem + 47360 + wave * 544);
    const u64 lt_mask2 = (lane == 0) ? 0ull : (~0ull >> (64 - lane));
    const unsigned trbase = (unsigned)(size_t)gbuf + (unsigned)((quad * 4 + ((lane & 15) >> 2)) * 336 + (lane & 3) * 8);
    for (int pp = 0; pp < 2; ++pp) {
      const int pair = wave * 2 + pp;
      int n = 0;
      for (int ch = 0; ch < nch; ++ch) {
        const u64 ma = maskL[(pair * 2) * 64 + ch], mb = maskL[(pair * 2 + 1) * 64 + ch];
        const u64 u = ma | mb;
        if (u == 0ull) continue;
        if ((u >> lane) & 1ull) {
          const int pos = n + __popcll(u & lt_mask2);
          idxL[pos] = (u16)(ch * 64 + lane);
          flL[pos] = (unsigned char)(((ma >> lane) & 1ull) | (((mb >> lane) & 1ull) << 1));
        }
        n += __popcll(u);
      }
      const int npad = (n + 31) & ~31;
      if (lane < npad - n) { idxL[n + lane] = 0; flL[n + lane] = 0; }
      const int ngr = npad >> 5;
      bf16x8 qf[5];
#pragma unroll
      for (int ks = 0; ks < 5; ++ks) qf[ks] = ld8(P_QC + ((tb + t0 + pair * 2 + (lr >> 3)) * 8 + (lr & 7)) * 160 + ks * 32 + quad * 8);
      float m = NEG_INF, l = 0.f;
      f32x4 o[8];
#pragma unroll
      for (int dt = 0; dt < 8; ++dt) o[dt] = f32x4{0.f, 0.f, 0.f, 0.f};
      const int qsel = lr >> 3;
      uint4 gv0, gv1, gv2, gv3, gv4, gv5, gv6, gv7, gv8, gv9;
#define GLOAD(I, G) do { const int pc_ = lane + 64 * (I); const int slot_ = pc_ / 20, piece_ = pc_ - slot_ * 20; \
        const int key_ = idxL[(G) * 32 + slot_]; gv##I = *reinterpret_cast<const uint4*>(P_KVC + (tb + key_) * 160 + piece_ * 8); } while (0)
#define GSTORE(I) do { const int pc_ = lane + 64 * (I); const int slot_ = pc_ / 20, piece_ = pc_ - slot_ * 20; \
        *reinterpret_cast<uint4*>(gbuf + slot_ * 336 + piece_ * 16) = gv##I; } while (0)
      if (ngr > 0) { GLOAD(0, 0); GLOAD(1, 0); GLOAD(2, 0); GLOAD(3, 0); GLOAD(4, 0); GLOAD(5, 0); GLOAD(6, 0); GLOAD(7, 0); GLOAD(8, 0); GLOAD(9, 0); }
      else { gv0 = gv1 = gv2 = gv3 = gv4 = gv5 = gv6 = gv7 = gv8 = gv9 = make_uint4(0u, 0u, 0u, 0u); }
      for (int g = 0; g < ngr; ++g) {
        GSTORE(0); GSTORE(1); GSTORE(2); GSTORE(3); GSTORE(4); GSTORE(5); GSTORE(6); GSTORE(7); GSTORE(8); GSTORE(9);
        if (g + 1 < ngr) { GLOAD(0, g + 1); GLOAD(1, g + 1); GLOAD(2, g + 1); GLOAD(3, g + 1); GLOAD(4, g + 1); GLOAD(5, g + 1); GLOAD(6, g + 1); GLOAD(7, g + 1); GLOAD(8, g + 1); GLOAD(9, g + 1); }
        f32x4 st[2];
#pragma unroll
        for (int kt = 0; kt < 2; ++kt) {
          st[kt] = f32x4{0.f, 0.f, 0.f, 0.f};
#pragma unroll
          for (int ks = 0; ks < 5; ++ks) {
            bf16x8 kf = *reinterpret_cast<const bf16x8*>(gbuf + (kt * 16 + lr) * 336 + ks * 64 + quad * 16);
            st[kt] = mfma16(kf, qf[ks], st[kt]);
          }
        }
        float cm = NEG_INF;
#pragma unroll
        for (int kt = 0; kt < 2; ++kt) {
          const unsigned fw = *reinterpret_cast<const unsigned*>(flL + g * 32 + kt * 16 + quad * 4);
#pragma unroll
          for (int j = 0; j < 4; ++j) {
            const bool v = ((fw >> (8 * j + qsel)) & 1u) != 0u;
            const float sv = v ? st[kt][j] : NEG_INF;
            st[kt][j] = sv; cm = fmaxf(cm, sv);
          }
        }
        cm = xq_max(cm);
        if (!__all(cm <= m + 8.f)) {
          const float mn = fmaxf(m, cm);
          const float msn = (mn == NEG_INF) ? 0.f : mn;
          const float alpha = fexp2(m - msn);
          m = mn;
          l *= alpha;
#pragma unroll
          for (int dt = 0; dt < 8; ++dt) { o[dt][0] *= alpha; o[dt][1] *= alpha; o[dt][2] *= alpha; o[dt][3] *= alpha; }
        }
        const float ms = (m == NEG_INF) ? 0.f : m;
        float ps = 0.f;
#pragma unroll
        for (int kt = 0; kt < 2; ++kt)
#pragma unroll
          for (int j = 0; j < 4; ++j) { const float pv = fexp2(st[kt][j] - ms); st[kt][j] = pv; ps += pv; }
        l += ps;
        const bf16x8 pb = pack8(st[0][0], st[0][1], st[0][2], st[0][3], st[1][0], st[1][1], st[1][2], st[1][3]);
        uint2 ta[8], tc[8];
        asm volatile(
            "s_waitcnt lgkmcnt(0)\n\t"
            "ds_read_b64_tr_b16 %0, %16\n\t"
            "ds_read_b64_tr_b16 %1, %16 offset:32\n\t"
            "ds_read_b64_tr_b16 %2, %16 offset:64\n\t"
            "ds_read_b64_tr_b16 %3, %16 offset:96\n\t"
            "ds_read_b64_tr_b16 %4, %16 offset:128\n\t"
            "ds_read_b64_tr_b16 %5, %16 offset:160\n\t"
            "ds_read_b64_tr_b16 %6, %16 offset:192\n\t"
            "ds_read_b64_tr_b16 %7, %16 offset:224\n\t"
            "ds_read_b64_tr_b16 %8, %16 offset:5376\n\t"
            "ds_read_b64_tr_b16 %9, %16 offset:5408\n\t"
            "ds_read_b64_tr_b16 %10, %16 offset:5440\n\t"
            "ds_read_b64_tr_b16 %11, %16 offset:5472\n\t"
            "ds_read_b64_tr_b16 %12, %16 offset:5504\n\t"
            "ds_read_b64_tr_b16 %13, %16 offset:5536\n\t"
            "ds_read_b64_tr_b16 %14, %16 offset:5568\n\t"
            "ds_read_b64_tr_b16 %15, %16 offset:5600\n\t"
            "s_waitcnt lgkmcnt(0)"
            : "=&v"(ta[0]), "=&v"(ta[1]), "=&v"(ta[2]), "=&v"(ta[3]), "=&v"(ta[4]), "=&v"(ta[5]), "=&v"(ta[6]), "=&v"(ta[7]),
              "=&v"(tc[0]), "=&v"(tc[1]), "=&v"(tc[2]), "=&v"(tc[3]), "=&v"(tc[4]), "=&v"(tc[5]), "=&v"(tc[6]), "=&v"(tc[7])
            : "v"(trbase)
            : "memory");
#pragma unroll
        for (int dt = 0; dt < 8; ++dt) {
          union { bf16x8 v; unsigned u[4]; } vf;
          vf.u[0] = ta[dt].x; vf.u[1] = ta[dt].y; vf.u[2] = tc[dt].x; vf.u[3] = tc[dt].y;
          o[dt] = mfma16(vf.v, pb, o[dt]);
        }
      }
      const float inv = 1.f / quad_sum(l);
      u16* op = P_OLAT + ((tb + t0 + pair * 2 + qsel) * 8 + (lr & 7)) * 128 + quad * 4;
#pragma unroll
      for (int dt = 0; dt < 8; ++dt) st8b(op + dt * 16, o[dt][0] * inv, o[dt][1] * inv, o[dt][2] * inv, o[dt][3] * inv);
    }
  }
  __threadfence_block();
  __syncthreads();
#pragma unroll
  for (int c = 0; c < 2; ++c) {
    const int h = wave * 2 + c;
    f32x4 res[4];
#pragma unroll
    for (int dvt = 0; dvt < 4; ++dvt) res[dvt] = f32x4{0.f, 0.f, 0.f, 0.f};
#pragma unroll
    for (int g = 0; g < 4; ++g) {
      const bf16x8 pbv = ld8(P_OLAT + ((tb + t0 + lr) * 8 + h) * 128 + g * 32 + quad * 8);
#pragma unroll
      for (int dvt = 0; dvt < 4; ++dvt) {
        const bf16x8 wf = ld8(P_WUVp + ((size_t)(h * 64 + dvt * 16 + lr)) * 128 + g * 32 + quad * 8);
        res[dvt] = mfma16(wf, pbv, res[dvt]);
      }
    }
    const size_t base = (tb + t0 + lr) * 1024 + h * 64 + quad * 4;
#pragma unroll
    for (int dvt = 0; dvt < 4; ++dvt) {
      uint2 sg = *reinterpret_cast<const uint2*>(P_SG + base + dvt * 16);
      float g0 = bf2f((u16)(sg.x & 0xFFFF)), g1 = bf2f((u16)(sg.x >> 16)), g2 = bf2f((u16)(sg.y & 0xFFFF)), g3 = bf2f((u16)(sg.y >> 16));
      st8b(P_OG + base + dvt * 16, res[dvt][0] * g0, res[dvt][1] * g1, res[dvt][2] * g2, res[dvt][3] * g3);
    }
  }
}

DEV void phase_attn(const Params& p, int layer, char* smem, int tid_in, int ctr_idx, int it_lo, int it_hi) {
  int* s_item = reinterpret_cast<int*>(smem + 73728);
  for (;;) {
    const int tid = opq(tid_in);
    const int wave = tid >> 6, lane = tid & 63;
    if (tid == 0) *s_item = atomicAdd(P_ctr + ctr_idx, 1);
    __syncthreads();
    const int it = *s_item + it_lo;
    __syncthreads();
    if (it >= it_hi) break;
    if (layer == 0) {
      if (it < 1024) { const int qt = 31 - (it >> 5), bh = it & 31; moba_item(p, bh >> 3, bh & 7, qt, wave, lane, smem); }
      else { const int i = it - 1024; const int t32 = i >> 3, bk = i & 7; swa_item(p, bk >> 1, bk & 1, t32, wave, lane, smem); }
    } else {
      if (it < 1024) { const int tile16 = 255 - (it >> 2), b = it & 3; dsa_item(p, b, tile16, smem, tid); }
      else { const int i = it - 1024; const int qt = i >> 5, bh = i & 31; sb_item(p, bh >> 3, bh & 7, qt, wave, lane); }
    }
  }
}

__global__ void __launch_bounds__(256, 2) fwd_megakernel(Params p) {
  __shared__ __attribute__((aligned(16))) char smem[73728 + 64];
  cg::grid_group grid = cg::this_grid();
  __shared__ uint4 xb_words;
  if (threadIdx.x == 0) xb_words = make_uint4(0u, 0u, 0u, 0u);
  __syncthreads();
  XcdBarrier xb = xcd_barrier_post(P_bar, (volatile LAS unsigned*)&xb_words);
  if (p.out == nullptr) grid.sync();
#define OPQ_TID() ({ int t_; asm volatile("v_mov_b32 %0, %1" : "=v"(t_) : "v"((int)threadIdx.x)); t_; })
#define GSYNC() xcd_barrier(xb)
#define VID() ((int)((volatile LAS unsigned*)&xb_words)[3])
  phase0(p, smem, OPQ_TID());
  GSYNC();
  phase_prep(p, 0, OPQ_TID());
  GSYNC();
  phase_inproj(p, 0, smem, OPQ_TID(), VID());
#if DBL == 1
  GSYNC(); phase_inproj(p, 0, smem, OPQ_TID(), VID());
#endif
  GSYNC();
  phase_attn(p, 0, smem, OPQ_TID(), 0, 0, 2048);
#if DBL == 2
  GSYNC(); phase_attn(p, 0, smem, OPQ_TID(), 2, 0, 1024);
#elif DBL == 7
  GSYNC(); phase_attn(p, 0, smem, OPQ_TID(), 2, 1024, 2048);
#endif
  GSYNC();
  phase_outproj(p, 0, smem, OPQ_TID(), VID());
#if DBL == 3
  GSYNC(); phase_outproj(p, 0, smem, OPQ_TID(), VID());
#endif
  GSYNC();
  phase_prep(p, 1, OPQ_TID());
  GSYNC();
  phase_inproj(p, 1, smem, OPQ_TID(), VID());
#if DBL == 4
  GSYNC(); phase_inproj(p, 1, smem, OPQ_TID(), VID());
#endif
  GSYNC();
  phase_attn(p, 1, smem, OPQ_TID(), 1, 0, 2048);
#if DBL == 5
  GSYNC(); phase_attn(p, 1, smem, OPQ_TID(), 3, 0, 1024);
#elif DBL == 6
  GSYNC(); phase_attn(p, 1, smem, OPQ_TID(), 3, 1024, 2048);
#endif
  GSYNC();
  phase_outproj(p, 1, smem, OPQ_TID(), VID());
  GSYNC();
  phase_final_ln(p, OPQ_TID());
}

extern "C" void kernel_launch(void* const* d_in, const int* in_sizes, int n_in, void* d_out, int out_size,
                              void* d_ws, size_t ws_size, hipStream_t stream) {
  static int grid_blocks = 0;
  if (!grid_blocks) {
    int dev = 0, cus = 0, per_cu = 0;
    hipGetDevice(&dev);
    hipDeviceGetAttribute(&cus, hipDeviceAttributeMultiprocessorCount, dev);
    hipOccupancyMaxActiveBlocksPerMultiprocessor(&per_cu, fwd_megakernel, 256, 0);
    if (per_cu < 1) per_cu = 1;
    if (per_cu > 2) per_cu = 2;
    grid_blocks = cus * per_cu;
  }
  Params p{};
  p.x = (const float*)d_in[0]; p.c = (const float*)d_in[1]; p.w_ada = (const float*)d_in[2]; p.b_ada = (const float*)d_in[3];
  p.w_in_even = (const float*)d_in[4]; p.sinks = (const float*)d_in[5]; p.w_in_odd = (const float*)d_in[6]; p.kvg = (const float*)d_in[7];
  p.w_uk = (const float*)d_in[8]; p.w_uv = (const float*)d_in[9]; p.w_out = (const float*)d_in[10]; p.ln_g = (const float*)d_in[11]; p.ln_b = (const float*)d_in[12];
  p.out = (float*)d_out;
  p.ws = (char*)d_ws;
  if (WS_NEEDED > ws_size) { fprintf(stderr, "workspace too small: need %zu have %zu\n", (size_t)WS_NEEDED, ws_size); return; }
  hipMemsetAsync(p.ws + 24871168ull, 0, (size_t)XCD_BAR_WORDS * 4, stream);
  void* args[] = {&p};
  hipError_t e = hipLaunchCooperativeKernel((void*)fwd_megakernel, dim3(grid_blocks), dim3(256), args, 0, stream);
  if (e != hipSuccess) fprintf(stderr, "cooperative launch failed: %s (grid %d)\n", hipGetErrorString(e), grid_blocks);
}
```

```cpp
#include <hip/hip_runtime.h>
#include <hip/hip_cooperative_groups.h>
#include <cstdio>
namespace cg = cooperative_groups;

typedef unsigned short u16;
typedef unsigned long long u64;
typedef __attribute__((ext_vector_type(8))) short bf16x8;
typedef __attribute__((ext_vector_type(4))) float f32x4;

#define DBL 0
#define DEV __device__ __forceinline__
#define NEG_INF (-__builtin_inff())

static constexpr int SEQ = 4096;
static constexpr int NTOK = 16384;
static constexpr int DM = 1024;
static constexpr int EVEN_IN = 3328;
static constexpr int ODD_IN = 3784;
static constexpr int ODD_N = 4352;
static constexpr float LOG2E = 1.4426950408889634f;
static constexpr float LN_EPS = 1e-5f;
static constexpr float DN_ALPHA = 1.4142135623730951f;

struct Params {
  const float *x, *c, *w_ada, *b_ada, *w_in_even, *sinks, *w_in_odd, *kvg, *w_uk, *w_uv, *w_out, *ln_g, *ln_b;
  float* out;
  char* ws;
};
#define P_WTe (reinterpret_cast<u16*>(p.ws + 0ull))
#define P_WTo (reinterpret_cast<u16*>(p.ws + 6815744ull))
#define P_WOT (reinterpret_cast<u16*>(p.ws + 15728640ull))
#define P_WUVp (reinterpret_cast<u16*>(p.ws + 19922944ull))
#define P_mods (reinterpret_cast<float*>(p.ws + 20054016ull))
#define P_cos64 (reinterpret_cast<float*>(p.ws + 20152320ull))
#define P_sin64 (reinterpret_cast<float*>(p.ws + 20676608ull))
#define P_cos32 (reinterpret_cast<float*>(p.ws + 21200896ull))
#define P_sin32 (reinterpret_cast<float*>(p.ws + 21463040ull))
#define P_kpart (reinterpret_cast<float*>(p.ws + 21725184ull))
#define P_stats0 (reinterpret_cast<float*>(p.ws + 22249472ull))
#define P_stats1 (reinterpret_cast<float*>(p.ws + 23298048ull))
#define P_IW (reinterpret_cast<float*>(p.ws + 24346624ull))
#define P_ctr (reinterpret_cast<int*>(p.ws + 24870912ull))
#define P_bar (reinterpret_cast<unsigned*>(p.ws + 24871168ull))
#define P_SG (reinterpret_cast<u16*>(p.ws + 24884992ull))
#define P_OG (reinterpret_cast<u16*>(p.ws + 58439424ull))
#define P_AQ (reinterpret_cast<u16*>(p.ws + 91993856ull))
#define P_AK (reinterpret_cast<u16*>(p.ws + 108771072ull))
#define P_AVt (reinterpret_cast<u16*>(p.ws + 125548288ull))
#define P_BQ (reinterpret_cast<u16*>(p.ws + 142325504ull))
#define P_BKk (reinterpret_cast<u16*>(p.ws + 159102720ull))
#define P_BVt (reinterpret_cast<u16*>(p.ws + 163297024ull))
#define P_QC (reinterpret_cast<u16*>(p.ws + 91993856ull))
#define P_V1B (reinterpret_cast<u16*>(p.ws + 91993856ull))
#define P_KVC (reinterpret_cast<u16*>(p.ws + 133936896ull))
#define P_CKVt (reinterpret_cast<u16*>(p.ws + 139179776ull))
#define P_IQ (reinterpret_cast<u16*>(p.ws + 143374080ull))
#define P_IK (reinterpret_cast<u16*>(p.ws + 151762688ull))
#define P_DQ (reinterpret_cast<u16*>(p.ws + 152811264ull))
#define P_DK (reinterpret_cast<u16*>(p.ws + 169588480ull))
#define P_DVt (reinterpret_cast<u16*>(p.ws + 186365696ull))
#define P_OLAT (reinterpret_cast<u16*>(p.ws + 203142912ull))
#define P_H (reinterpret_cast<u16*>(p.ws + 203142912ull))
static constexpr size_t WS_NEEDED = 236697344ull;

DEV int opq(int x) { asm volatile("" : "+v"(x)); return x; }
DEV u16 f2bf(float f) { unsigned u = __float_as_uint(f); u += 0x7FFFu + ((u >> 16) & 1u); return (u16)(u >> 16); }
DEV float bf2f(u16 h) { return __uint_as_float(((unsigned)h) << 16); }
DEV unsigned pack2(float a, float b) { unsigned r; asm("v_cvt_pk_bf16_f32 %0, %1, %2" : "=v"(r) : "v"(a), "v"(b)); return r; }
DEV bf16x8 pack8(float a0, float a1, float a2, float a3, float a4, float a5, float a6, float a7) {
  union { bf16x8 v; unsigned u[4]; } r;
  r.u[0] = pack2(a0, a1); r.u[1] = pack2(a2, a3); r.u[2] = pack2(a4, a5); r.u[3] = pack2(a6, a7);
  return r.v;
}
DEV bf16x8 ld8(const u16* p) { return *reinterpret_cast<const bf16x8*>(p); }
DEV f32x4 mfma16(bf16x8 a, bf16x8 b, f32x4 c) { return __builtin_amdgcn_mfma_f32_16x16x32_bf16(a, b, c, 0, 0, 0); }
DEV float fexp2(float x) { return __builtin_amdgcn_exp2f(x); }
DEV float fexp(float x) { return __builtin_amdgcn_exp2f(x * LOG2E); }
DEV float flog(float x) { return __builtin_amdgcn_logf(x) * 0.6931471805599453f; }
DEV float silu_f(float x) { return x / (1.f + fexp(-x)); }
DEV void st8b(u16* p, float a, float b, float c, float d) { uint2 v; v.x = pack2(a, b); v.y = pack2(c, d); *reinterpret_cast<uint2*>(p) = v; }
DEV void st16b(u16* p, const float* v) { uint4 u; u.x = pack2(v[0], v[1]); u.y = pack2(v[2], v[3]); u.z = pack2(v[4], v[5]); u.w = pack2(v[6], v[7]); *reinterpret_cast<uint4*>(p) = u; }


#define XB_TMO      128
#define XB_XCNT(j)  (256  + 64 * (j))
#define XB_XSUB(j)  (1280 + 64 * (j))
#define XB_XGEN(j)  (2304 + 64 * (j))
#define XB_TOP      3328
#define XB_TOPGEN   3392
#define XCD_BAR_WORDS 3456
#define XB_SPIN_CAP (1u << 18)
#define LAS __attribute__((address_space(3)))
DEV unsigned xb_ld(unsigned* p)              { return __hip_atomic_load(p, __ATOMIC_RELAXED, __HIP_MEMORY_SCOPE_AGENT); }
DEV unsigned xb_add(unsigned* p, unsigned v) { return __hip_atomic_fetch_add(p, v, __ATOMIC_RELAXED, __HIP_MEMORY_SCOPE_AGENT); }
DEV unsigned xb_xcc_id() { return (unsigned)__builtin_amdgcn_s_getreg((3 << 11) | 20) & 0xFu; }
#define XB_SPIN(cond, bar) do { unsigned _sp = 0; while (cond) { __builtin_amdgcn_s_sleep(1); \
    if ((++_sp & 255u) == 0u) { if (xb_ld(&(bar)[XB_TMO])) break; if (_sp > XB_SPIN_CAP) { atomicAdd(&(bar)[XB_TMO], 1u); break; } } } } while (0)
struct XcdBarrier { unsigned* bar; unsigned x; volatile LAS unsigned* st; };
DEV XcdBarrier xcd_barrier_post(unsigned* bar, volatile LAS unsigned* st) {
  XcdBarrier b; b.bar = bar; b.x = xb_xcc_id(); b.st = st;
  if (threadIdx.x == 0) st[2] = xb_add(&bar[XB_XCNT(b.x)], 1u);
  return b;
}
DEV void xcd_barrier_complete(unsigned* bar, unsigned x, unsigned& nloc, unsigned& nx, unsigned& before) {
  const unsigned G = gridDim.x * gridDim.y * gridDim.z;
  unsigned sum, cnt, mine, bef, sp = 0u;
  for (;;) {
    sum = 0u; cnt = 0u; mine = 0u; bef = 0u;
#pragma unroll
    for (unsigned j = 0; j < 16; ++j) { const unsigned c = xb_ld(&bar[XB_XCNT(j)]); sum += c; cnt += (c > 0u) ? 1u : 0u; mine = (j == x) ? c : mine; bef += (j < x) ? c : 0u; }
    if (sum == G) break;
    __builtin_amdgcn_s_sleep(1);
    if ((++sp & 255u) == 0u) { if (xb_ld(&bar[XB_TMO])) break; if (sp > XB_SPIN_CAP) { atomicAdd(&bar[XB_TMO], 1u); break; } }
  }
  nloc = mine > 0u ? mine : 1u; nx = cnt > 0u ? cnt : 1u; before = bef;
}
DEV void xcd_barrier(const XcdBarrier& b) {
  asm volatile("s_waitcnt vmcnt(0)" ::: "memory");
  __syncthreads();
  if (threadIdx.x == 0) {
    unsigned* bar = b.bar;
    __builtin_amdgcn_s_waitcnt(0);
    unsigned nloc = b.st[0], nx = b.st[1];
    if (nloc == 0u) { unsigned bef; xcd_barrier_complete(bar, b.x, nloc, nx, bef); b.st[0] = nloc; b.st[1] = nx; b.st[3] = bef + b.st[2]; }
    const unsigned old = xb_add(&bar[XB_XSUB(b.x)], 1u);
    const unsigned gen = old / nloc;
    if (old + 1u == (gen + 1u) * nloc) {
      __builtin_amdgcn_fence(__ATOMIC_RELEASE, "agent");
      asm volatile("s_waitcnt vmcnt(0)" ::: "memory");
      const unsigned og = xb_add(&bar[XB_TOP], 1u);
      const unsigned tg = og / nx;
      if (og + 1u == (tg + 1u) * nx) xb_add(&bar[XB_TOPGEN], 1u);
      else XB_SPIN(xb_ld(&bar[XB_TOPGEN]) == tg, bar);
      __builtin_amdgcn_fence(__ATOMIC_ACQUIRE, "agent");
      xb_add(&bar[XB_XGEN(b.x)], 1u);
      asm volatile("s_waitcnt vmcnt(0)" ::: "memory");
    } else {
      XB_SPIN(xb_ld(&bar[XB_XGEN(b.x)]) == gen, bar);
      __builtin_amdgcn_fence(__ATOMIC_ACQUIRE, "agent");
      asm volatile("s_waitcnt vmcnt(0)" ::: "memory");
    }
  }
  __syncthreads();
}

DEV int odd_srccol(int n) {
  if (n < 1024) return -1;
  if (n < 1280) return 512 + (n - 1024);
  if (n < 1408) return 768 + (n - 1280);
  if (n < 1536) { int j = n - 1408; if (j < 32) return 896 + j; if (j < 64) return 1184 + (j - 32); if (j < 72) return 1216 + (j - 64); return -1; }
  if (n < 1792) return 928 + (n - 1536);
  if (n < 3328) return 1224 + (n - 1792);
  return 2760 + (n - 3328);
}

DEV void p0_transpose(const float* __restrict__ src, int ld, int mapmode, u16* __restrict__ dst, int n0, int k0, float* tile, int tid) {
  const int n = tid & 63;
  const int dn = n0 + n;
  const int sc = mapmode ? odd_srccol(dn) : dn;
#pragma unroll
  for (int i = 0; i < 16; ++i) {
    int kr = (tid >> 6) + 4 * i;
    tile[kr * 65 + n] = (sc >= 0) ? src[(size_t)(k0 + kr) * ld + sc] : 0.f;
  }
  __syncthreads();
#pragma unroll
  for (int i = 0; i < 16; ++i) {
    int nr = (tid >> 6) + 4 * i;
    int k = tid & 63;
    dst[(size_t)(n0 + nr) * 1024 + k0 + k] = f2bf(tile[k * 65 + nr]);
  }
  __syncthreads();
}

DEV void phase0(const Params& p, char* smem, int tid_in) {
  float* fs = reinterpret_cast<float*>(smem);
  const int NITEM = 96 + 512 + 2176 + 64;
  for (int it = blockIdx.x; it < NITEM; it += gridDim.x) {
    const int tid = opq(tid_in);
    if (it < 96) {
      const int col0 = it * 64; const int l = col0 / 3072; const int n0 = col0 % 3072;
      float* sc = fs;
      float* red = fs + 4096;
      for (int e = tid; e < 4096; e += 256) sc[e] = silu_f(p.c[e]);
      __syncthreads();
      const int cgp = tid & 15, ks = tid >> 4;
      float acc[4][4];
#pragma unroll
      for (int b = 0; b < 4; ++b) for (int e = 0; e < 4; ++e) acc[b][e] = 0.f;
      const float* wp = p.w_ada + ((size_t)l * 1024 + ks * 64) * 3072 + n0 + cgp * 4;
#pragma unroll 8
      for (int k = 0; k < 64; ++k) {
        float4 w = *reinterpret_cast<const float4*>(wp + (size_t)k * 3072);
#pragma unroll
        for (int b = 0; b < 4; ++b) {
          float s = sc[b * 1024 + ks * 64 + k];
          acc[b][0] += s * w.x; acc[b][1] += s * w.y; acc[b][2] += s * w.z; acc[b][3] += s * w.w;
        }
      }
#pragma unroll
      for (int b = 0; b < 4; ++b) for (int e = 0; e < 4; ++e) red[(ks * 4 + b) * 64 + cgp * 4 + e] = acc[b][e];
      __syncthreads();
      {
        const int b = tid >> 6, n = tid & 63;
        float s = 0.f;
#pragma unroll
        for (int k2 = 0; k2 < 16; ++k2) s += red[(k2 * 4 + b) * 64 + n];
        P_mods[(size_t)(l * 4 + b) * 3072 + n0 + n] = s + p.b_ada[l * 3072 + n0 + n];
      }
      __syncthreads();
    } else if (it < 608) {
      const int i = it - 96; const int h = i >> 6; const int k0 = ((i >> 2) & 15) * 64; const int cq = i & 3;
      float* Wk = fs;
#pragma unroll
      for (int r = 0; r < 16; ++r) {
        int kk = (tid >> 6) + 4 * r; int d = tid & 63;
        Wk[kk * 65 + d] = p.w_in_odd[(size_t)(k0 + kk) * ODD_IN + h * 64 + d];
      }
      __syncthreads();
      const int kk = tid & 63; const int cgp = tid >> 6;
      float wk[64];
#pragma unroll
      for (int d = 0; d < 64; ++d) wk[d] = Wk[kk * 65 + d];
#pragma unroll 2
      for (int cc = 0; cc < 8; ++cc) {
        const int cidx = cq * 32 + cgp * 8 + cc;
        const float* uk = p.w_uk + ((size_t)(h * 128 + cidx)) * 64;
        float a = 0.f;
#pragma unroll
        for (int d = 0; d < 64; ++d) a += wk[d] * uk[d];
        P_WTo[(size_t)(h * 128 + cidx) * 1024 + k0 + kk] = f2bf(a);
      }
      __syncthreads();
    } else if (it < 608 + 2176) {
      const int i = it - 608;
      if (i < 832) { p0_transpose(p.w_in_even, EVEN_IN, 0, P_WTe, (i >> 4) * 64, (i & 15) * 64, fs, tid); }
      else if (i < 1664) { int j = i - 832; p0_transpose(p.w_in_odd, ODD_IN, 1, P_WTo, 1024 + (j >> 4) * 64, (j & 15) * 64, fs, tid); }
      else { int j = i - 1664; int l = j >> 8; int jj = j & 255; p0_transpose(p.w_out + (size_t)l * 1024 * 1024, 1024, 0, P_WOT + (size_t)l * 1024 * 1024, (jj >> 4) * 64, (jj & 15) * 64, fs, tid); }
    } else {
      const int i = it - 2784;
      const int gtid = i * 256 + tid; const int gstr = 64 * 256;
      if (gtid == 0) { P_ctr[0] = 0; P_ctr[1] = 0; P_ctr[2] = 0; P_ctr[3] = 0; }
      for (int e = gtid; e < 4096 * 32; e += gstr) {
        int pos = e >> 5, f = e & 31;
        float inv = 1.0f / powf(10000.f, (float)(2 * f) / 64.f);
        float ang = (float)pos * inv;
        double rev = (double)ang * 0.15915494309189535; rev -= floor(rev);
        float fr = (float)rev;
        P_cos64[e] = __builtin_amdgcn_cosf(fr); P_sin64[e] = __builtin_amdgcn_sinf(fr);
      }
      for (int e = gtid; e < 4096 * 16; e += gstr) {
        int pos = e >> 4, f = e & 15;
        float inv = 1.0f / powf(10000.f, (float)(2 * f) / 32.f);
        float ang = (float)pos * inv;
        double rev = (double)ang * 0.15915494309189535; rev -= floor(rev);
        float fr = (float)rev;
        P_cos32[e] = __builtin_amdgcn_cosf(fr); P_sin32[e] = __builtin_amdgcn_sinf(fr);
      }
      for (int e = gtid; e < 8 * 128 * 64; e += gstr) {
        int cidx = e & 127, dv = (e >> 7) & 63, h = e >> 13;
        P_WUVp[e] = f2bf(p.w_uv[((size_t)(h * 128 + cidx)) * 64 + dv]);
      }
    }
  }
}

static constexpr int LDA_S = 72;
static constexpr int CS_LD = 132;
static constexpr int ROWSTAT_OFF = 67584;

DEV void row_stats_from_partials(const float* __restrict__ stats, int row, float& mu, float& rstd) {
  const float4* sp = reinterpret_cast<const float4*>(stats + (size_t)row * 16);
  float s = 0.f, ss = 0.f;
#pragma unroll
  for (int i = 0; i < 4; ++i) { float4 v = sp[i]; s += v.x + v.z; ss += v.y + v.w; }
  mu = s * (1.f / 1024.f);
  float var = ss * (1.f / 1024.f) - mu * mu;
  rstd = rsqrtf(fmaxf(var, 0.f) + LN_EPS);
}

template <bool AF32>
DEV void gemm_mainloop(const void* __restrict__ Aptr, const u16* __restrict__ Bt, int m0, int n0,
                       const float* __restrict__ lng, const float* __restrict__ lnb,
                       const float* __restrict__ msc, const float* __restrict__ msh,
                       const float* __restrict__ stats, char* smem, f32x4 (&acc)[4][4], int tid) {
  float* rowstat = reinterpret_cast<float*>(smem + ROWSTAT_OFF);
  const int wave = tid >> 6, lane = tid & 63, lr = lane & 15, quad = lane >> 4;
  const int wm = wave >> 1, wn = wave & 1;
#pragma unroll
  for (int i = 0; i < 4; ++i)
#pragma unroll
    for (int j = 0; j < 4; ++j) acc[i][j] = f32x4{0.f, 0.f, 0.f, 0.f};

  float rmu0 = 0.f, rmu1 = 0.f, rmu2 = 0.f, rmu3 = 0.f, rmu4 = 0.f, rmu5 = 0.f, rmu6 = 0.f, rmu7 = 0.f;
  float rrs0 = 1.f, rrs1 = 1.f, rrs2 = 1.f, rrs3 = 1.f, rrs4 = 1.f, rrs5 = 1.f, rrs6 = 1.f, rrs7 = 1.f;
  if (AF32) {
    if (tid < 128) {
      float mu = 0.f, rs = 1.f;
      if (stats) row_stats_from_partials(stats, m0 + tid, mu, rs);
      rowstat[tid * 2] = mu; rowstat[tid * 2 + 1] = rs;
    }
    __syncthreads();
#define RS_LD(I) { int r = (tid >> 4) + 16 * I; rmu##I = rowstat[r * 2]; rrs##I = rowstat[r * 2 + 1]; }
    RS_LD(0) RS_LD(1) RS_LD(2) RS_LD(3) RS_LD(4) RS_LD(5) RS_LD(6) RS_LD(7)
#undef RS_LD
  }

  uint4 b0, b1, b2, b3, a0, a1, a2, a3;
  float4 f0, f1, f2, f3, f4, f5, f6, f7;
  const int brow = tid >> 3, bpc = tid & 7;
  const u16* bsrc = Bt + (size_t)(n0 + brow) * 1024 + bpc * 8;
  const u16* asrc16 = reinterpret_cast<const u16*>(Aptr) + (size_t)(m0 + brow) * 1024 + bpc * 8;
  const int acg = tid & 15, arow = tid >> 4;
  const float* asrc32 = reinterpret_cast<const float*>(Aptr) + (size_t)(m0 + arow) * 1024 + acg * 4;
  const int bst = brow * 128 + ((bpc ^ ((brow >> 1) & 7)) << 4);
  const int ast = arow * 128 + ((((acg >> 1) ^ ((arow >> 1) & 7))) << 4) + (acg & 1) * 8;
  const int fsw = (lr >> 1) & 7;
  const int ard = (wm * 64 + lr) * 128, brd = 16384 + (wn * 64 + lr) * 128;
  const int fo0 = ((quad ^ fsw) << 4), fo1 = (((4 + quad) ^ fsw) << 4);

#define GEMM_LOAD_TILE(KT) do { const int k0_ = (KT) * 64; \
    b0 = *reinterpret_cast<const uint4*>(bsrc + k0_); b1 = *reinterpret_cast<const uint4*>(bsrc + k0_ + 32 * 1024); \
    b2 = *reinterpret_cast<const uint4*>(bsrc + k0_ + 64 * 1024); b3 = *reinterpret_cast<const uint4*>(bsrc + k0_ + 96 * 1024); \
    if (AF32) { \
      f0 = *reinterpret_cast<const float4*>(asrc32 + (size_t)(0) * 1024 + k0_);  f1 = *reinterpret_cast<const float4*>(asrc32 + (size_t)(16) * 1024 + k0_); \
      f2 = *reinterpret_cast<const float4*>(asrc32 + (size_t)(32) * 1024 + k0_); f3 = *reinterpret_cast<const float4*>(asrc32 + (size_t)(48) * 1024 + k0_); \
      f4 = *reinterpret_cast<const float4*>(asrc32 + (size_t)(64) * 1024 + k0_); f5 = *reinterpret_cast<const float4*>(asrc32 + (size_t)(80) * 1024 + k0_); \
      f6 = *reinterpret_cast<const float4*>(asrc32 + (size_t)(96) * 1024 + k0_); f7 = *reinterpret_cast<const float4*>(asrc32 + (size_t)(112) * 1024 + k0_); \
    } else { \
      a0 = *reinterpret_cast<const uint4*>(asrc16 + k0_); a1 = *reinterpret_cast<const uint4*>(asrc16 + k0_ + 32 * 1024); \
      a2 = *reinterpret_cast<const uint4*>(asrc16 + k0_ + 64 * 1024); a3 = *reinterpret_cast<const uint4*>(asrc16 + k0_ + 96 * 1024); \
    } } while (0)
#define GEMM_AFF(FV, I) do { \
    float q0_ = ((FV).x - rmu##I) * rrs##I * G.x + Bv.x; float q1_ = ((FV).y - rmu##I) * rrs##I * G.y + Bv.y; \
    float q2_ = ((FV).z - rmu##I) * rrs##I * G.z + Bv.z; float q3_ = ((FV).w - rmu##I) * rrs##I * G.w + Bv.w; \
    uint2 pk_; pk_.x = pack2(q0_, q1_); pk_.y = pack2(q2_, q3_); \
    *reinterpret_cast<uint2*>(sb_ + ast + (I) * 2048) = pk_; } while (0)
#define GEMM_STORE_TILE(KT, STG) do { char* sb_ = smem + (STG) * 32768; \
      *reinterpret_cast<uint4*>(sb_ + 16384 + bst) = b0; *reinterpret_cast<uint4*>(sb_ + 16384 + bst + 4096) = b1; \
      *reinterpret_cast<uint4*>(sb_ + 16384 + bst + 8192) = b2; *reinterpret_cast<uint4*>(sb_ + 16384 + bst + 12288) = b3; \
      if (AF32) { \
        const int k = (KT) * 64 + acg * 4; \
        float4 sc = *reinterpret_cast<const float4*>(msc + k); \
        float4 sh = *reinterpret_cast<const float4*>(msh + k); \
        float4 G, Bv; \
        if (lng) { \
          float4 g = *reinterpret_cast<const float4*>(lng + k); \
          float4 bb = *reinterpret_cast<const float4*>(lnb + k); \
          G.x = g.x * (1.f + sc.x); G.y = g.y * (1.f + sc.y); G.z = g.z * (1.f + sc.z); G.w = g.w * (1.f + sc.w); \
          Bv.x = bb.x * (1.f + sc.x) + sh.x; Bv.y = bb.y * (1.f + sc.y) + sh.y; Bv.z = bb.z * (1.f + sc.z) + sh.z; Bv.w = bb.w * (1.f + sc.w) + sh.w; \
        } else { \
          G.x = 1.f + sc.x; G.y = 1.f + sc.y; G.z = 1.f + sc.z; G.w = 1.f + sc.w; \
          Bv = sh; \
        } \
        GEMM_AFF(f0, 0); GEMM_AFF(f1, 1); GEMM_AFF(f2, 2); GEMM_AFF(f3, 3); \
        GEMM_AFF(f4, 4); GEMM_AFF(f5, 5); GEMM_AFF(f6, 6); GEMM_AFF(f7, 7); \
      } else { \
        *reinterpret_cast<uint4*>(sb_ + bst) = a0; *reinterpret_cast<uint4*>(sb_ + bst + 4096) = a1; \
        *reinterpret_cast<uint4*>(sb_ + bst + 8192) = a2; *reinterpret_cast<uint4*>(sb_ + bst + 12288) = a3; \
      } } while (0)

  GEMM_LOAD_TILE(0);
  GEMM_STORE_TILE(0, 0);
  GEMM_LOAD_TILE(1);
  __syncthreads();
  for (int kt = 0; kt < 16; ++kt) {
    const int cur = kt & 1;
    if (kt + 1 < 16) GEMM_STORE_TILE(kt + 1, cur ^ 1);
    if (kt + 2 < 16) GEMM_LOAD_TILE(kt + 2);
    {
      const char* sb = smem + cur * 32768;
      bf16x8 af0[4], bf0[4], af1[4], bf1[4];
#pragma unroll
      for (int mi = 0; mi < 4; ++mi) af0[mi] = *reinterpret_cast<const bf16x8*>(sb + ard + mi * 2048 + fo0);
#pragma unroll
      for (int ni = 0; ni < 4; ++ni) bf0[ni] = *reinterpret_cast<const bf16x8*>(sb + brd + ni * 2048 + fo0);
#pragma unroll
      for (int mi = 0; mi < 4; ++mi) af1[mi] = *reinterpret_cast<const bf16x8*>(sb + ard + mi * 2048 + fo1);
#pragma unroll
      for (int ni = 0; ni < 4; ++ni) bf1[ni] = *reinterpret_cast<const bf16x8*>(sb + brd + ni * 2048 + fo1);
      __builtin_amdgcn_sched_barrier(0);
#pragma unroll
      for (int mi = 0; mi < 4; ++mi)
#pragma unroll
        for (int ni = 0; ni < 4; ++ni) acc[mi][ni] = mfma16(af0[mi], bf0[ni], acc[mi][ni]);
#pragma unroll
      for (int mi = 0; mi < 4; ++mi)
#pragma unroll
        for (int ni = 0; ni < 4; ++ni) acc[mi][ni] = mfma16(af1[mi], bf1[ni], acc[mi][ni]);
    }
    __syncthreads();
  }
}

DEV void stage_all(f32x4 (&acc)[4][4], float* Cs, int tid) {
  const int wave = tid >> 6, lane = tid & 63, lr = lane & 15, quad = lane >> 4;
  const int wm = wave >> 1, wn = wave & 1;
#pragma unroll
  for (int mi = 0; mi < 4; ++mi)
#pragma unroll
    for (int ni = 0; ni < 4; ++ni)
#pragma unroll
      for (int j = 0; j < 4; ++j) Cs[(wm * 64 + mi * 16 + quad * 4 + j) * CS_LD + wn * 64 + ni * 16 + lr] = acc[mi][ni][j];
}

DEV void ld8f(const float* src, float* v) {
  const float4 a = *reinterpret_cast<const float4*>(src), c = *reinterpret_cast<const float4*>(src + 4);
  v[0] = a.x; v[1] = a.y; v[2] = a.z; v[3] = a.w; v[4] = c.x; v[5] = c.y; v[6] = c.z; v[7] = c.w;
}

DEV void epi_rope64(const Params& p, float* Cs, u16* dst, int H, int h0, float scale, bool do_kpart, int b, int pos0, int tid) {
  const int pc = tid & 15, hh = pc >> 3, j0 = (pc & 7) * 4;
#pragma unroll
  for (int ps = 0; ps < 8; ++ps) {
    const int row = ps * 16 + (tid >> 4);
    const int pos = pos0 + row;
    float* cp = Cs + row * CS_LD + hh * 64 + j0;
    const float4 x1 = *reinterpret_cast<const float4*>(cp), x2 = *reinterpret_cast<const float4*>(cp + 32);
    const float4 c = *reinterpret_cast<const float4*>(P_cos64 + (size_t)pos * 32 + j0);
    const float4 sn = *reinterpret_cast<const float4*>(P_sin64 + (size_t)pos * 32 + j0);
    float4 o1, o2;
    o1.x = (x1.x * c.x - x2.x * sn.x) * scale; o2.x = (x2.x * c.x + x1.x * sn.x) * scale;
    o1.y = (x1.y * c.y - x2.y * sn.y) * scale; o2.y = (x2.y * c.y + x1.y * sn.y) * scale;
    o1.z = (x1.z * c.z - x2.z * sn.z) * scale; o2.z = (x2.z * c.z + x1.z * sn.z) * scale;
    o1.w = (x1.w * c.w - x2.w * sn.w) * scale; o2.w = (x2.w * c.w + x1.w * sn.w) * scale;
    u16* d = dst + ((size_t)((b * H + h0 + hh) * SEQ + pos)) * 64 + j0;
    st8b(d, o1.x, o1.y, o1.z, o1.w); st8b(d + 32, o2.x, o2.y, o2.z, o2.w);
    if (do_kpart) { *reinterpret_cast<float4*>(cp) = o1; *reinterpret_cast<float4*>(cp + 32) = o2; }
  }
  if (do_kpart) {
    __syncthreads();
    const int col = tid & 127, hf = tid >> 7;
    float sm = 0.f;
    for (int r = 0; r < 64; ++r) sm += Cs[(hf * 64 + r) * CS_LD + col];
    P_kpart[((size_t)((b * 8 + h0 + (col >> 6)) * 64 + (pos0 >> 6) + hf)) * 64 + (col & 63)] = sm;
  }
}

DEV void epi_plain_hm(const float* Cs, u16* dst, int H, int h0, float scale, int b, int pos0, int tid) {
  const int pc = tid & 15, hh = pc >> 3, j0 = (pc & 7) * 8;
#pragma unroll
  for (int ps = 0; ps < 8; ++ps) {
    const int row = ps * 16 + (tid >> 4);
    float v[8]; ld8f(Cs + row * CS_LD + pc * 8, v);
#pragma unroll
    for (int e = 0; e < 8; ++e) v[e] *= scale;
    st16b(dst + ((size_t)((b * H + h0 + hh) * SEQ + pos0 + row)) * 64 + j0, v);
  }
}

DEV void epi_vt(const float* Cs, u16* dst, int H, int h0, int DH, int b, int pos0, int tid) {
  for (int idx = tid; idx < 2048; idx += 256) {
    const int quad = idx & 3, c = (idx >> 2) & 127, g = idx >> 9;
    const int h = h0 + c / DH, d = c % DH;
    float v[8];
#pragma unroll
    for (int e = 0; e < 8; ++e) { int srow = g * 32 + (e >> 2) * 16 + quad * 4 + (e & 3); v[e] = Cs[srow * CS_LD + c]; }
    st16b(dst + (((size_t)((b * H + h) * 128 + (pos0 >> 5) + g)) * DH + d) * 32 + quad * 8, v);
  }
}

DEV void epi_silu(const float* Cs, u16* dst, int col0, int tok0, int tid) {
  const int pc = tid & 15;
#pragma unroll
  for (int ps = 0; ps < 8; ++ps) {
    const int row = ps * 16 + (tid >> 4);
    float v[8]; ld8f(Cs + row * CS_LD + pc * 8, v);
#pragma unroll
    for (int e = 0; e < 8; ++e) v[e] = silu_f(v[e]);
    st16b(dst + (size_t)(tok0 + row) * 1024 + col0 + pc * 8, v);
  }
}

DEV void rope32_piece(const Params& p, const float* Cs, int row, int pos, int ch, int j0, float scale, float4& o1, float4& o2) {
  const float* cp = Cs + row * CS_LD + ch * 32 + j0;
  const float4 x1 = *reinterpret_cast<const float4*>(cp), x2 = *reinterpret_cast<const float4*>(cp + 16);
  const float4 c = *reinterpret_cast<const float4*>(P_cos32 + (size_t)pos * 16 + j0);
  const float4 sn = *reinterpret_cast<const float4*>(P_sin32 + (size_t)pos * 16 + j0);
  o1.x = (x1.x * c.x - x2.x * sn.x) * scale; o2.x = (x2.x * c.x + x1.x * sn.x) * scale;
  o1.y = (x1.y * c.y - x2.y * sn.y) * scale; o2.y = (x2.y * c.y + x1.y * sn.y) * scale;
  o1.z = (x1.z * c.z - x2.z * sn.z) * scale; o2.z = (x2.z * c.z + x1.z * sn.z) * scale;
  o1.w = (x1.w * c.w - x2.w * sn.w) * scale; o2.w = (x2.w * c.w + x1.w * sn.w) * scale;
}

DEV void epilogue_inproj(const Params& p, int layer, int nt, float* Cs, int b, int pos0, int tid) {
  const int tok0 = b * SEQ + pos0;
  const int pc = tid & 15;
  if (layer == 0) {
    if (nt < 4) epi_rope64(p, Cs, P_AQ, 8, 2 * nt, 0.125f * LOG2E, false, b, pos0, tid);
    else if (nt < 8) epi_rope64(p, Cs, P_AK, 8, 2 * (nt - 4), 1.f, true, b, pos0, tid);
    else if (nt < 12) epi_vt(Cs, P_AVt, 8, 2 * (nt - 8), 64, b, pos0, tid);
    else if (nt < 16) epi_rope64(p, Cs, P_BQ, 8, 2 * (nt - 12), 0.125f * LOG2E, false, b, pos0, tid);
    else if (nt == 16) epi_rope64(p, Cs, P_BKk, 2, 0, 1.f, false, b, pos0, tid);
    else if (nt == 17) epi_vt(Cs, P_BVt, 2, 0, 64, b, pos0, tid);
    else epi_silu(Cs, P_SG, (nt - 18) * 128, tok0, tid);
  } else {
    const float qscale = 0.10206207261596575f * LOG2E;
    if (nt < 8) {
#pragma unroll
      for (int ps = 0; ps < 8; ++ps) {
        const int row = ps * 16 + (tid >> 4);
        float v[8]; ld8f(Cs + row * CS_LD + pc * 8, v);
#pragma unroll
        for (int e = 0; e < 8; ++e) v[e] *= qscale;
        st16b(P_QC + ((size_t)(tok0 + row) * 8 + nt) * 160 + pc * 8, v);
      }
    } else if (nt < 10 || nt == 12 || nt == 13) {
      const bool isq = nt < 10;
      const int ch = pc >> 2, j0 = (pc & 3) * 4;
      const int h = 4 * (isq ? (nt - 8) : (nt - 12)) + ch;
#pragma unroll
      for (int ps = 0; ps < 8; ++ps) {
        const int row = ps * 16 + (tid >> 4);
        float4 o1, o2; rope32_piece(p, Cs, row, pos0 + row, ch, j0, isq ? qscale : 1.f, o1, o2);
        u16* d = isq ? (P_QC + ((size_t)(tok0 + row) * 8 + h) * 160 + 128 + j0) : (P_IQ + ((size_t)(tok0 + row) * 8 + h) * 32 + j0);
        st8b(d, o1.x, o1.y, o1.z, o1.w); st8b(d + 16, o2.x, o2.y, o2.z, o2.w);
      }
    } else if (nt == 10) {
      float kg[8];
      ld8f(p.kvg + pc * 8, kg);
#pragma unroll
      for (int ps = 0; ps < 8; ++ps) {
        const int row = ps * 16 + (tid >> 4);
        float v[8]; ld8f(Cs + row * CS_LD + pc * 8, v);
        float ss = 0.f;
#pragma unroll
        for (int e = 0; e < 8; ++e) ss += v[e] * v[e];
        ss += __shfl_xor(ss, 1); ss += __shfl_xor(ss, 2); ss += __shfl_xor(ss, 4); ss += __shfl_xor(ss, 8);
        const float rinv = rsqrtf(ss * (1.f / 128.f) + LN_EPS);
#pragma unroll
        for (int e = 0; e < 8; ++e) { v[e] = v[e] * rinv * kg[e]; Cs[row * CS_LD + pc * 8 + e] = v[e]; }
        st16b(P_KVC + (size_t)(tok0 + row) * 160 + pc * 8, v);
      }
      __syncthreads();
      epi_vt(Cs, P_CKVt, 1, 0, 128, b, pos0, tid);
    } else if (nt == 11) {
      const int ch = pc >> 2, j0 = (pc & 3) * 4;
#pragma unroll
      for (int ps = 0; ps < 8; ++ps) {
        const int row = ps * 16 + (tid >> 4);
        if (ch < 2) {
          float4 o1, o2; rope32_piece(p, Cs, row, pos0 + row, ch, j0, 1.f, o1, o2);
          u16* d = (ch == 0) ? (P_KVC + (size_t)(tok0 + row) * 160 + 128 + j0) : (P_IK + (size_t)(tok0 + row) * 32 + j0);
          st8b(d, o1.x, o1.y, o1.z, o1.w); st8b(d + 16, o2.x, o2.y, o2.z, o2.w);
        } else if (pc == 8 || pc == 9) {
          const float4 w = *reinterpret_cast<const float4*>(Cs + row * CS_LD + 64 + (pc - 8) * 4);
          *reinterpret_cast<float4*>(P_IW + (size_t)(tok0 + row) * 8 + (pc - 8) * 4) = w;
        }
      }
    } else if (nt < 18) epi_plain_hm(Cs, P_DQ, 8, 2 * (nt - 14), 0.125f, b, pos0, tid);
    else if (nt < 22) epi_plain_hm(Cs, P_DK, 8, 2 * (nt - 18), 1.f, b, pos0, tid);
    else if (nt < 26) epi_vt(Cs, P_DVt, 8, 2 * (nt - 22), 64, b, pos0, tid);
    else epi_silu(Cs, P_SG, (nt - 26) * 128, tok0, tid);
  }
}

DEV void phase_inproj(const Params& p, int layer, char* smem, int tid_in, int vid) {
  const int NT = layer == 0 ? 26 : 34;
  const int total = 128 * NT;
  float* Cs = reinterpret_cast<float*>(smem);
  const int G = gridDim.x;
  const int nfull = total / G, ntail = total - nfull * G;
  const int tstride = (ntail > 0 && (G % ntail) == 0) ? (G / ntail) : 1;
  const bool has_tail = (ntail > 0) && ((tstride > 1) ? ((vid % tstride) == 0) : (vid < ntail));
  const int nmine = nfull + (has_tail ? 1 : 0);
  for (int rr = 0; rr < nmine; ++rr) {
    const int it = (rr < nfull) ? (rr * G + vid) : (nfull * G + ((tstride > 1) ? (vid / tstride) : vid));
    const int tid = opq(tid_in);
    const int panel = it / (8 * NT), rem = it % (8 * NT);
    const int nt = rem >> 3, mt = panel * 8 + (rem & 7);
    const int m0 = mt * 128, n0 = nt * 128;
    const int b = m0 >> 12;
    f32x4 acc[4][4];
    gemm_mainloop<false>(P_H, layer == 0 ? P_WTe : P_WTo, m0, n0, nullptr, nullptr, nullptr, nullptr, nullptr, smem, acc, tid);
    stage_all(acc, Cs, tid);
    __syncthreads();
    epilogue_inproj(p, layer, nt, Cs, b, (m0 & 4095), tid);
    __syncthreads();
  }
}

DEV float half32_sum_at31(float v) {
  float x = v;
  x += __builtin_amdgcn_update_dpp(0.f, x, 0x111, 0xf, 0xf, false);
  x += __builtin_amdgcn_update_dpp(0.f, x, 0x112, 0xf, 0xf, false);
  x += __builtin_amdgcn_update_dpp(0.f, x, 0x114, 0xf, 0xf, false);
  x += __builtin_amdgcn_update_dpp(0.f, x, 0x118, 0xf, 0xf, false);
  const auto r = __builtin_amdgcn_permlane16_swap(__float_as_uint(x), __float_as_uint(x), false, false);
  return __uint_as_float(r[0]) + __uint_as_float(r[1]);
}
DEV void phase_outproj(const Params& p, int layer, char* smem, int tid_in, int vid) {
  float* Cs = reinterpret_cast<float*>(smem);
  float* rowstat = reinterpret_cast<float*>(smem + ROWSTAT_OFF);
  const u16* Bt = P_WOT + (size_t)layer * 1024 * 1024;
  float* stats_out = layer == 0 ? P_stats0 : P_stats1;
  for (int it = vid; it < 128 * 8; it += gridDim.x) {
    const int tid = opq(tid_in);
    const int nt = (it >> 3) & 7, mt = (it >> 6) * 8 + (it & 7);
    const int m0 = mt * 128, n0 = nt * 128;
    const int b = m0 >> 12;
    f32x4 acc[4][4];
    gemm_mainloop<false>(P_OG, Bt, m0, n0, nullptr, nullptr, nullptr, nullptr, nullptr, smem, acc, tid);
    if (layer == 1) {
      if (tid < 128) { float mu, rs; row_stats_from_partials(P_stats0, m0 + tid, mu, rs); rowstat[tid * 2] = mu; rowstat[tid * 2 + 1] = rs; }
    }
    const float* gate = P_mods + (size_t)(layer * 4 + b) * 3072 + 2048;
    stage_all(acc, Cs, tid);
    __syncthreads();
    {
      const int l32 = tid & 31, rgrp = tid >> 5;
      const int gc = n0 + l32 * 4;
      const float4 gt = *reinterpret_cast<const float4*>(gate + gc);
      float4 lg = make_float4(0.f, 0.f, 0.f, 0.f), lb = lg;
      if (layer == 1) { lg = *reinterpret_cast<const float4*>(p.ln_g + gc); lb = *reinterpret_cast<const float4*>(p.ln_b + gc); }
#pragma unroll 4
      for (int ps = 0; ps < 16; ++ps) {
        const int lrow = ps * 8 + rgrp;
        const size_t grow = (size_t)(m0 + lrow);
        float4 xr;
        if (layer == 0) xr = *reinterpret_cast<const float4*>(p.x + grow * 1024 + gc);
        else {
          const float mu = rowstat[lrow * 2], rs = rowstat[lrow * 2 + 1];
          const float4 v0 = *reinterpret_cast<const float4*>(p.out + grow * 1024 + gc);
          xr.x = (v0.x - mu) * rs * lg.x + lb.x; xr.y = (v0.y - mu) * rs * lg.y + lb.y;
          xr.z = (v0.z - mu) * rs * lg.z + lb.z; xr.w = (v0.w - mu) * rs * lg.w + lb.w;
        }
        const float4 y = *reinterpret_cast<const float4*>(Cs + lrow * CS_LD + l32 * 4);
        float4 v;
        v.x = DN_ALPHA * xr.x + (1.f + gt.x) * y.x; v.y = DN_ALPHA * xr.y + (1.f + gt.y) * y.y;
        v.z = DN_ALPHA * xr.z + (1.f + gt.z) * y.z; v.w = DN_ALPHA * xr.w + (1.f + gt.w) * y.w;
        float sm = v.x + v.y + v.z + v.w, ss = v.x * v.x + v.y * v.y + v.z * v.z + v.w * v.w;
        if (layer == 1) st8b(P_V1B + grow * 1024 + gc, v.x, v.y, v.z, v.w);
        else *reinterpret_cast<float4*>(p.out + grow * 1024 + gc) = v;
        sm = half32_sum_at31(sm); ss = half32_sum_at31(ss);
        if (l32 == 31) { stats_out[grow * 16 + nt * 2] = sm; stats_out[grow * 16 + nt * 2 + 1] = ss; }
      }
    }
    __syncthreads();
  }
}

DEV void phase_prep(const Params& p, int layer, int tid) {
  const int lane = tid & 63;
  const int gw = blockIdx.x * 4 + (tid >> 6), nw = gridDim.x * 4;
  for (int row = gw; row < NTOK; row += nw) {
    const int b = row >> 12;
    const float* modb = P_mods + (size_t)(layer * 4 + b) * 3072;
    const float* src = (layer == 0 ? p.x : p.out) + (size_t)row * 1024;
    float mu = 0.f, rs = 1.f;
    if (layer == 1) row_stats_from_partials(P_stats0, row, mu, rs);
    u16* dst = P_H + (size_t)row * 1024;
#pragma unroll
    for (int i = 0; i < 4; ++i) {
      const int c = i * 256 + lane * 4;
      float4 v = *reinterpret_cast<const float4*>(src + c);
      if (layer == 1) {
        const float4 g = *reinterpret_cast<const float4*>(p.ln_g + c);
        const float4 bb = *reinterpret_cast<const float4*>(p.ln_b + c);
        v.x = (v.x - mu) * rs * g.x + bb.x; v.y = (v.y - mu) * rs * g.y + bb.y;
        v.z = (v.z - mu) * rs * g.z + bb.z; v.w = (v.w - mu) * rs * g.w + bb.w;
      }
      const float4 sh = *reinterpret_cast<const float4*>(modb + c);
      const float4 sc = *reinterpret_cast<const float4*>(modb + 1024 + c);
      st8b(dst + c, v.x * (1.f + sc.x) + sh.x, v.y * (1.f + sc.y) + sh.y, v.z * (1.f + sc.z) + sh.z, v.w * (1.f + sc.w) + sh.w);
    }
  }
}

DEV void phase_final_ln(const Params& p, int tid) {
  const int lane = tid & 63;
  const int gw = blockIdx.x * 4 + (tid >> 6), nw = gridDim.x * 4;
  const float* g = p.ln_g + 1024; const float* bb = p.ln_b + 1024;
  for (int row = gw; row < NTOK; row += nw) {
    float mu, rs; row_stats_from_partials(P_stats1, row, mu, rs);
    float* rp = p.out + (size_t)row * 1024;
    const u16* vp = P_V1B + (size_t)row * 1024;
#pragma unroll
    for (int i = 0; i < 4; ++i) {
      const int c = i * 256 + lane * 4;
      const uint2 vb = *reinterpret_cast<const uint2*>(vp + c);
      float4 v;
      v.x = bf2f((u16)(vb.x & 0xFFFF)); v.y = bf2f((u16)(vb.x >> 16)); v.z = bf2f((u16)(vb.y & 0xFFFF)); v.w = bf2f((u16)(vb.y >> 16));
      float4 gg = *reinterpret_cast<const float4*>(g + c);
      float4 b4 = *reinterpret_cast<const float4*>(bb + c);
      v.x = (v.x - mu) * rs * gg.x + b4.x; v.y = (v.y - mu) * rs * gg.y + b4.y;
      v.z = (v.z - mu) * rs * gg.z + b4.z; v.w = (v.w - mu) * rs * gg.w + b4.w;
      *reinterpret_cast<float4*>(rp + c) = v;
    }
  }
}

DEV float xq_max(float x) {
  unsigned u = __float_as_uint(x);
  auto r = __builtin_amdgcn_permlane32_swap(u, u, false, false);
  const float m = fmaxf(__uint_as_float(r[0]), __uint_as_float(r[1]));
  unsigned v = __float_as_uint(m);
  auto s2 = __builtin_amdgcn_permlane16_swap(v, v, false, false);
  return fmaxf(__uint_as_float(s2[0]), __uint_as_float(s2[1]));
}
DEV float xq_sum(float x) {
  unsigned u = __float_as_uint(x);
  auto r = __builtin_amdgcn_permlane32_swap(u, u, false, false);
  const float m = __uint_as_float(r[0]) + __uint_as_float(r[1]);
  unsigned v = __float_as_uint(m);
  auto s2 = __builtin_amdgcn_permlane16_swap(v, v, false, false);
  return __uint_as_float(s2[0]) + __uint_as_float(s2[1]);
}
template <int NKS, int NDT, class MaskF>
DEV void flash_chunk(const u16* __restrict__ Kc, int ldk, const u16* __restrict__ Vc, const bf16x8 (&qf)[2][NKS],
                     float (&m)[2], float (&l)[2], f32x4 (&o)[NDT][2], int lane, MaskF mask) {
  const int lr = lane & 15, quad = lane >> 4;
  f32x4 st[4][2];
#pragma unroll
  for (int kt = 0; kt < 4; ++kt) { st[kt][0] = f32x4{0.f, 0.f, 0.f, 0.f}; st[kt][1] = f32x4{0.f, 0.f, 0.f, 0.f}; }
#pragma unroll
  for (int kt = 0; kt < 4; ++kt)
#pragma unroll
    for (int ks = 0; ks < NKS; ++ks) {
      bf16x8 kf = ld8(Kc + (size_t)(kt * 16 + lr) * ldk + ks * 32 + quad * 8);
      st[kt][0] = mfma16(kf, qf[0][ks], st[kt][0]);
      st[kt][1] = mfma16(kf, qf[1][ks], st[kt][1]);
    }
#pragma unroll
  for (int c = 0; c < 2; ++c) {
    float cm = NEG_INF;
#pragma unroll
    for (int kt = 0; kt < 4; ++kt)
#pragma unroll
      for (int j = 0; j < 4; ++j) { float s = mask(kt, j, c) ? st[kt][c][j] : NEG_INF; st[kt][c][j] = s; cm = fmaxf(cm, s); }
    cm = xq_max(cm);
    const float mn = fmaxf(m[c], cm);
    const float ms = (mn == NEG_INF) ? 0.f : mn;
    const float alpha = fexp2(m[c] - ms);
    m[c] = mn;
    float ps = 0.f;
#pragma unroll
    for (int kt = 0; kt < 4; ++kt)
#pragma unroll
      for (int j = 0; j < 4; ++j) { float pv = fexp2(st[kt][c][j] - ms); st[kt][c][j] = pv; ps += pv; }
    l[c] = l[c] * alpha + ps;
#pragma unroll
    for (int dt = 0; dt < NDT; ++dt) { o[dt][c][0] *= alpha; o[dt][c][1] *= alpha; o[dt][c][2] *= alpha; o[dt][c][3] *= alpha; }
  }
  bf16x8 pb[2][2];
#pragma unroll
  for (int c = 0; c < 2; ++c)
#pragma unroll
    for (int g = 0; g < 2; ++g)
      pb[c][g] = pack8(st[2 * g][c][0], st[2 * g][c][1], st[2 * g][c][2], st[2 * g][c][3],
                       st[2 * g + 1][c][0], st[2 * g + 1][c][1], st[2 * g + 1][c][2], st[2 * g + 1][c][3]);
#pragma unroll
  for (int g = 0; g < 2; ++g)
#pragma unroll
    for (int dt = 0; dt < NDT; ++dt) {
      bf16x8 vf = ld8(Vc + ((size_t)((g * NDT + dt) * 16 + lr) * 4 + quad) * 8);
      o[dt][0] = mfma16(vf, pb[0][g], o[dt][0]);
      o[dt][1] = mfma16(vf, pb[1][g], o[dt][1]);
    }
}

DEV void load_kv64(const u16* __restrict__ Kc, const u16* __restrict__ Vc, bf16x8 (&kf)[4][2], bf16x8 (&vf)[2][4], int lane) {
  const int lr = lane & 15, quad = lane >> 4;
#pragma unroll
  for (int kt = 0; kt < 4; ++kt)
#pragma unroll
    for (int ks = 0; ks < 2; ++ks) kf[kt][ks] = ld8(Kc + (size_t)(kt * 16 + lr) * 64 + ks * 32 + quad * 8);
#pragma unroll
  for (int g = 0; g < 2; ++g)
#pragma unroll
    for (int dt = 0; dt < 4; ++dt) vf[g][dt] = ld8(Vc + ((size_t)((g * 4 + dt) * 16 + lr) * 4 + quad) * 8);
}
DEV void copy_kv64(bf16x8 (&kd)[4][2], bf16x8 (&vd)[2][4], const bf16x8 (&ks_)[4][2], const bf16x8 (&vs)[2][4]) {
#pragma unroll
  for (int a = 0; a < 4; ++a) { kd[a][0] = ks_[a][0]; kd[a][1] = ks_[a][1]; }
#pragma unroll
  for (int g = 0; g < 2; ++g)
#pragma unroll
    for (int dt = 0; dt < 4; ++dt) vd[g][dt] = vs[g][dt];
}
template <class MaskF>
DEV void flash_chunk_pre(const bf16x8 (&kf)[4][2], const bf16x8 (&vf)[2][4], const bf16x8 (&qf)[2][2],
                         float (&m)[2], float (&l)[2], f32x4 (&o)[4][2], int lane, MaskF mask) {
  f32x4 st[4][2];
#pragma unroll
  for (int kt = 0; kt < 4; ++kt) {
    st[kt][0] = f32x4{0.f, 0.f, 0.f, 0.f}; st[kt][1] = f32x4{0.f, 0.f, 0.f, 0.f};
#pragma unroll
    for (int ks = 0; ks < 2; ++ks) { st[kt][0] = mfma16(kf[kt][ks], qf[0][ks], st[kt][0]); st[kt][1] = mfma16(kf[kt][ks], qf[1][ks], st[kt][1]); }
  }
#pragma unroll
  for (int c = 0; c < 2; ++c) {
    float cm = NEG_INF;
#pragma unroll
    for (int kt = 0; kt < 4; ++kt)
#pragma unroll
      for (int j = 0; j < 4; ++j) { float sv = mask(kt, j, c) ? st[kt][c][j] : NEG_INF; st[kt][c][j] = sv; cm = fmaxf(cm, sv); }
    cm = xq_max(cm);
    if (!__all(cm <= m[c] + 8.f)) {
      const float mn = fmaxf(m[c], cm);
      const float msn = (mn == NEG_INF) ? 0.f : mn;
      const float alpha = fexp2(m[c] - msn);
      m[c] = mn;
      l[c] *= alpha;
#pragma unroll
      for (int dt = 0; dt < 4; ++dt) { o[dt][c][0] *= alpha; o[dt][c][1] *= alpha; o[dt][c][2] *= alpha; o[dt][c][3] *= alpha; }
    }
    const float ms = (m[c] == NEG_INF) ? 0.f : m[c];
    float ps = 0.f;
#pragma unroll
    for (int kt = 0; kt < 4; ++kt)
#pragma unroll
      for (int j = 0; j < 4; ++j) { float pv = fexp2(st[kt][c][j] - ms); st[kt][c][j] = pv; ps += pv; }
    l[c] += ps;
  }
#pragma unroll
  for (int g = 0; g < 2; ++g) {
    const bf16x8 p0 = pack8(st[2 * g][0][0], st[2 * g][0][1], st[2 * g][0][2], st[2 * g][0][3], st[2 * g + 1][0][0], st[2 * g + 1][0][1], st[2 * g + 1][0][2], st[2 * g + 1][0][3]);
    const bf16x8 p1 = pack8(st[2 * g][1][0], st[2 * g][1][1], st[2 * g][1][2], st[2 * g][1][3], st[2 * g + 1][1][0], st[2 * g + 1][1][1], st[2 * g + 1][1][2], st[2 * g + 1][1][3]);
#pragma unroll
    for (int dt = 0; dt < 4; ++dt) { o[dt][0] = mfma16(vf[g][dt], p0, o[dt][0]); o[dt][1] = mfma16(vf[g][dt], p1, o[dt][1]); }
  }
}

DEV void write_og4(const Params& p, f32x4 (&o)[4][2], const float (&inv)[2], int b, int tq0, int colbase, int lane) {
  const int lr = lane & 15, quad = lane >> 4;
#pragma unroll
  for (int c = 0; c < 2; ++c) {
    const size_t base = ((size_t)(b * SEQ + tq0 + c * 16 + lr)) * 1024 + colbase + quad * 4;
#pragma unroll
    for (int dt = 0; dt < 4; ++dt) {
      uint2 sg = *reinterpret_cast<const uint2*>(P_SG + base + dt * 16);
      float g0 = bf2f((u16)(sg.x & 0xFFFF)), g1 = bf2f((u16)(sg.x >> 16)), g2 = bf2f((u16)(sg.y & 0xFFFF)), g3 = bf2f((u16)(sg.y >> 16));
      st8b(P_OG + base + dt * 16, o[dt][c][0] * inv[c] * g0, o[dt][c][1] * inv[c] * g1, o[dt][c][2] * inv[c] * g2, o[dt][c][3] * inv[c] * g3);
    }
  }
}

DEV float quad_sum(float v) { return xq_sum(v); }

DEV void moba_item(const Params& p, int b, int h, int qt, int wave, int lane, char* smem) {
  const int lr = lane & 15, quad = lane >> 4;
  const int q0 = qt * 128 + wave * 32;
  const int own = q0 >> 8;
  const size_t hb = (size_t)(b * 8 + h) * SEQ * 64;
  const u16* Q = P_AQ + hb; const u16* K = P_AK + hb; const u16* Vt = P_AVt + hb;
  bf16x8 qf[2][2];
#pragma unroll
  for (int c = 0; c < 2; ++c)
#pragma unroll
    for (int ks = 0; ks < 2; ++ks) qf[c][ks] = ld8(Q + (size_t)(q0 + c * 16 + lr) * 64 + ks * 32 + quad * 8);
  unsigned selmask[2] = {0u, 0u};
  if (own > 0) {
    bf16x8 kmf[2];
#pragma unroll
    for (int ks = 0; ks < 2; ++ks) {
      float s[8];
#pragma unroll
      for (int e = 0; e < 8; ++e) s[e] = 0.f;
      if (lr < own) {
#pragma unroll
        for (int part = 0; part < 4; ++part) {
          const float* kp = P_kpart + ((size_t)((b * 8 + h) * 64 + lr * 4 + part)) * 64 + ks * 32 + quad * 8;
          float4 a = *reinterpret_cast<const float4*>(kp); float4 bq = *reinterpret_cast<const float4*>(kp + 4);
          s[0] += a.x; s[1] += a.y; s[2] += a.z; s[3] += a.w; s[4] += bq.x; s[5] += bq.y; s[6] += bq.z; s[7] += bq.w;
        }
      }
      const float r = 1.f / 256.f;
      kmf[ks] = pack8(s[0] * r, s[1] * r, s[2] * r, s[3] * r, s[4] * r, s[5] * r, s[6] * r, s[7] * r);
    }
#pragma unroll
    for (int c = 0; c < 2; ++c) {
      f32x4 g = f32x4{0.f, 0.f, 0.f, 0.f};
      g = mfma16(kmf[0], qf[c][0], g); g = mfma16(kmf[1], qf[c][1], g);
      float v[4];
#pragma unroll
      for (int j = 0; j < 4; ++j) v[j] = (quad * 4 + j < own) ? g[j] : NEG_INF;
      unsigned sm = 0u;
#pragma unroll
      for (int itr = 0; itr < 3; ++itr) {
        float best = NEG_INF; int bi = 99;
#pragma unroll
        for (int j = 0; j < 4; ++j) if (v[j] > best) { best = v[j]; bi = quad * 4 + j; }
#pragma unroll
        for (int off = 16; off <= 32; off <<= 1) {
          float ob = __shfl_xor(best, off); int oi = __shfl_xor(bi, off);
          if (ob > best || (ob == best && oi < bi)) { best = ob; bi = oi; }
        }
        if (bi < 16) {
          sm |= 1u << bi;
#pragma unroll
          for (int j = 0; j < 4; ++j) if (quad * 4 + j == bi) v[j] = NEG_INF;
        }
      }
      selmask[c] = sm;
    }
  }
  float m[2] = {NEG_INF, NEG_INF}, l[2] = {0.f, 0.f};
  f32x4 o[4][2];
#pragma unroll
  for (int dt = 0; dt < 4; ++dt) { o[dt][0] = f32x4{0.f, 0.f, 0.f, 0.f}; o[dt][1] = f32x4{0.f, 0.f, 0.f, 0.f}; }
  {
    const int tid = wave * 64 + lane;
    const int cend_w = (q0 + 31) >> 6;
    const int cend_b = (qt * 128 + 127) >> 6;
    uint4 r0, r1, r2, r3;
    const int kid0 = tid, kid1 = tid + 256;
    const int krow0 = kid0 >> 3, kc0 = kid0 & 7, krow1 = kid1 >> 3, kc1 = kid1 & 7;
    const int kst0 = krow0 * 128 + ((kc0 ^ ((krow0 >> 1) & 7)) << 4), kst1 = krow1 * 128 + ((kc1 ^ ((krow1 >> 1) & 7)) << 4);
    const int vlr0 = (kid0 >> 2) & 15, vq0 = kid0 & 3, vlr1 = (kid1 >> 2) & 15, vq1 = kid1 & 3;
    const int vst0 = 8192 + (kid0 >> 6) * 1024 + vlr0 * 64 + ((vq0 ^ (vlr0 >= 8 ? 3 : 0)) << 4);
    const int vst1 = 8192 + (kid1 >> 6) * 1024 + vlr1 * 64 + ((vq1 ^ (vlr1 >= 8 ? 3 : 0)) << 4);
#define MOBA_LOAD(CH) do { const u16* kg_ = K + (size_t)(CH) * 64 * 64; const u16* vg_ = Vt + (size_t)(CH) * 2 * 64 * 32; \
      r0 = *reinterpret_cast<const uint4*>(kg_ + kid0 * 8); r1 = *reinterpret_cast<const uint4*>(kg_ + kid1 * 8); \
      r2 = *reinterpret_cast<const uint4*>(vg_ + kid0 * 8); r3 = *reinterpret_cast<const uint4*>(vg_ + kid1 * 8); } while (0)
#define MOBA_STORE(STG) do { char* sb_ = smem + (STG) * 16384; \
      *reinterpret_cast<uint4*>(sb_ + kst0) = r0; *reinterpret_cast<uint4*>(sb_ + kst1) = r1; \
      *reinterpret_cast<uint4*>(sb_ + vst0) = r2; *reinterpret_cast<uint4*>(sb_ + vst1) = r3; } while (0)
    const int kro = lr * 128, ksw = (lr >> 1) & 7;
    const int vro = 8192 + lr * 64 + ((quad ^ (lr >= 8 ? 3 : 0)) << 4);
    MOBA_LOAD(0);
    MOBA_STORE(0);
    if (cend_b >= 1) MOBA_LOAD(1);
    __syncthreads();
    for (int chk = 0; chk <= cend_b; ++chk) {
      if (chk + 1 <= cend_b) MOBA_STORE((chk + 1) & 1);
      if (chk + 2 <= cend_b) MOBA_LOAD(chk + 2);
      const int cb = chk * 64, n = chk >> 2;
      const bool past = n < own;
      const bool s0 = (selmask[0] >> n) & 1u, s1 = (selmask[1] >> n) & 1u;
      if (chk <= cend_w && (!past || __ballot(s0 || s1) != 0ull)) {
        const char* sb = smem + (chk & 1) * 16384;
        bf16x8 kc[4][2], vc[2][4];
#pragma unroll
        for (int kt = 0; kt < 4; ++kt)
#pragma unroll
          for (int ks = 0; ks < 2; ++ks) kc[kt][ks] = *reinterpret_cast<const bf16x8*>(sb + kt * 2048 + kro + (((ks * 4 + quad) ^ ksw) << 4));
#pragma unroll
        for (int g = 0; g < 2; ++g)
#pragma unroll
          for (int dt = 0; dt < 4; ++dt) vc[g][dt] = *reinterpret_cast<const bf16x8*>(sb + (g * 4 + dt) * 1024 + vro);
        flash_chunk_pre(kc, vc, qf, m, l, o, lane,
                        [&](int kt, int j, int c) { return past ? (c ? s1 : s0) : ((cb + kt * 16 + quad * 4 + j) <= (q0 + c * 16 + lr)); });
      }
      __syncthreads();
    }
  }
  float inv[2];
  inv[0] = 1.f / quad_sum(l[0]); inv[1] = 1.f / quad_sum(l[1]);
  write_og4(p, o, inv, b, q0, h * 64, lane);
}

DEV void swa_item(const Params& p, int b, int kvh, int t32, int wave, int lane, char* smem) {
  const int lr = lane & 15, quad = lane >> 4;
  const int q0 = t32 * 32;
  const int qh = kvh * 4 + wave;
  const u16* Q = P_BQ + (size_t)(b * 8 + qh) * SEQ * 64;
  const u16* K = P_BKk + (size_t)(b * 2 + kvh) * SEQ * 64;
  const u16* Vt = P_BVt + (size_t)(b * 2 + kvh) * SEQ * 64;
  bf16x8 qf[2][2];
#pragma unroll
  for (int c = 0; c < 2; ++c)
#pragma unroll
    for (int ks = 0; ks < 2; ++ks) qf[c][ks] = ld8(Q + (size_t)(q0 + c * 16 + lr) * 64 + ks * 32 + quad * 8);
  float m[2] = {NEG_INF, NEG_INF}, l[2] = {0.f, 0.f};
  f32x4 o[4][2];
#pragma unroll
  for (int dt = 0; dt < 4; ++dt) { o[dt][0] = f32x4{0.f, 0.f, 0.f, 0.f}; o[dt][1] = f32x4{0.f, 0.f, 0.f, 0.f}; }
  {
    const int tid = wave * 64 + lane;
    const int lo = (q0 - 127) > 0 ? (q0 - 127) : 0;
    const int c0 = lo >> 6, c1 = (q0 + 31) >> 6;
    uint4 r0, r1, r2, r3;
    const int kid0 = tid, kid1 = tid + 256;
    const int krow0 = kid0 >> 3, kc0 = kid0 & 7, krow1 = kid1 >> 3, kc1 = kid1 & 7;
    const int kst0 = krow0 * 128 + ((kc0 ^ ((krow0 >> 1) & 7)) << 4), kst1 = krow1 * 128 + ((kc1 ^ ((krow1 >> 1) & 7)) << 4);
    const int vlr0 = (kid0 >> 2) & 15, vq0 = kid0 & 3, vlr1 = (kid1 >> 2) & 15, vq1 = kid1 & 3;
    const int vst0 = 8192 + (kid0 >> 6) * 1024 + vlr0 * 64 + ((vq0 ^ (vlr0 >= 8 ? 3 : 0)) << 4);
    const int vst1 = 8192 + (kid1 >> 6) * 1024 + vlr1 * 64 + ((vq1 ^ (vlr1 >= 8 ? 3 : 0)) << 4);
    const int kro = lr * 128, ksw = (lr >> 1) & 7;
    const int vro = 8192 + lr * 64 + ((quad ^ (lr >= 8 ? 3 : 0)) << 4);
    MOBA_LOAD(c0);
    MOBA_STORE(0);
    if (c0 + 1 <= c1) MOBA_LOAD(c0 + 1);
    __syncthreads();
    for (int chk = c0; chk <= c1; ++chk) {
      const int stg = (chk - c0) & 1;
      if (chk + 1 <= c1) MOBA_STORE(stg ^ 1);
      if (chk + 2 <= c1) MOBA_LOAD(chk + 2);
      const int cb = chk * 64;
      {
        const char* sb = smem + stg * 16384;
        bf16x8 kc[4][2], vc[2][4];
#pragma unroll
        for (int kt = 0; kt < 4; ++kt)
#pragma unroll
          for (int ks = 0; ks < 2; ++ks) kc[kt][ks] = *reinterpret_cast<const bf16x8*>(sb + kt * 2048 + kro + (((ks * 4 + quad) ^ ksw) << 4));
#pragma unroll
        for (int g = 0; g < 2; ++g)
#pragma unroll
          for (int dt = 0; dt < 4; ++dt) vc[g][dt] = *reinterpret_cast<const bf16x8*>(sb + (g * 4 + dt) * 1024 + vro);
        flash_chunk_pre(kc, vc, qf, m, l, o, lane,
                        [&](int kt, int j, int c) { int key = cb + kt * 16 + quad * 4 + j; int t = q0 + c * 16 + lr; return key <= t && key > t - 128; });
      }
      __syncthreads();
    }
  }
  const float sl = p.sinks[qh] * LOG2E;
  float inv[2];
#pragma unroll
  for (int c = 0; c < 2; ++c) {
    float lt = quad_sum(l[c]);
    float mf = fmaxf(m[c], sl);
    float a = fexp2(m[c] - mf);
    inv[c] = a / (lt * a + fexp2(sl - mf));
  }
  write_og4(p, o, inv, b, q0, 512 + qh * 64, lane);
}

DEV void sb_item(const Params& p, int b, int h, int qt, int wave, int lane) {
  const int lr = lane & 15, quad = lane >> 4;
  const int q0 = qt * 128 + wave * 32;
  const size_t hb = (size_t)(b * 8 + h) * SEQ * 64;
  const u16* Q = P_DQ + hb; const u16* K = P_DK + hb; const u16* Vt = P_DVt + hb;
  bf16x8 qf[2][2];
#pragma unroll
  for (int c = 0; c < 2; ++c)
#pragma unroll
    for (int ks = 0; ks < 2; ++ks) qf[c][ks] = ld8(Q + (size_t)(q0 + c * 16 + lr) * 64 + ks * 32 + quad * 8);
  float carry[2] = {0.f, 0.f};
  f32x4 o[4][2];
#pragma unroll
  for (int dt = 0; dt < 4; ++dt) { o[dt][0] = f32x4{0.f, 0.f, 0.f, 0.f}; o[dt][1] = f32x4{0.f, 0.f, 0.f, 0.f}; }
  bf16x8 kc[4][2], kn[4][2], vc[2][4];
  {
    const u16* Kc0 = K + (size_t)((q0 + 31) >> 6) * 64 * 64;
#pragma unroll
    for (int kt = 0; kt < 4; ++kt)
#pragma unroll
      for (int ks = 0; ks < 2; ++ks) kc[kt][ks] = ld8(Kc0 + (size_t)(kt * 16 + lr) * 64 + ks * 32 + quad * 8);
  }
  for (int chk = (q0 + 31) >> 6; chk >= 0; --chk) {
    const int cb = chk * 64;
    {
      const u16* Vc = Vt + (size_t)chk * 2 * 64 * 32;
#pragma unroll
      for (int g = 0; g < 2; ++g)
#pragma unroll
        for (int dt = 0; dt < 4; ++dt) vc[g][dt] = ld8(Vc + ((size_t)((g * 4 + dt) * 16 + lr) * 4 + quad) * 8);
    }
    if (chk > 0) {
      const u16* Kn = K + (size_t)(chk - 1) * 64 * 64;
#pragma unroll
      for (int kt = 0; kt < 4; ++kt)
#pragma unroll
        for (int ks = 0; ks < 2; ++ks) kn[kt][ks] = ld8(Kn + (size_t)(kt * 16 + lr) * 64 + ks * 32 + quad * 8);
    }
    f32x4 st[4][2];
#pragma unroll
    for (int kt = 0; kt < 4; ++kt) {
      st[kt][0] = f32x4{0.f, 0.f, 0.f, 0.f}; st[kt][1] = f32x4{0.f, 0.f, 0.f, 0.f};
#pragma unroll
      for (int ks = 0; ks < 2; ++ks) { st[kt][0] = mfma16(kc[kt][ks], qf[0][ks], st[kt][0]); st[kt][1] = mfma16(kc[kt][ks], qf[1][ks], st[kt][1]); }
    }
#pragma unroll
    for (int c = 0; c < 2; ++c) {
      const int t = q0 + c * 16 + lr;
      float lk[4][4], hq[4], tot[4];
#pragma unroll
      for (int kt = 0; kt < 4; ++kt) {
        float g = 0.f;
#pragma unroll
        for (int j = 0; j < 4; ++j) {
          const int key = cb + kt * 16 + quad * 4 + j;
          const float z = st[kt][c][j];
          const float sp = fmaxf(z, 0.f) + flog(1.f + fexp(-fabsf(z)));
          const float v = (key < t) ? -sp : 0.f;
          lk[kt][j] = v; g += v;
        }
        const auto r16 = __builtin_amdgcn_permlane16_swap(__float_as_uint(g), __float_as_uint(g), false, false);
        const float od = __uint_as_float(r16[1]);
        const float psum = __uint_as_float(r16[0]) + od;
        const auto r32 = __builtin_amdgcn_permlane32_swap(__float_as_uint(psum), __float_as_uint(psum), false, false);
        const float p01 = __uint_as_float(r32[0]), p23 = __uint_as_float(r32[1]);
        hq[kt] = (quad == 0) ? (od + p23) : (quad == 1) ? p23 : (quad == 2) ? od : 0.f;
        tot[kt] = p01 + p23;
      }
      float run = carry[c];
#pragma unroll
      for (int kt = 3; kt >= 0; --kt) {
        const float base = run + hq[kt];
        float ex = 0.f;
#pragma unroll
        for (int j = 3; j >= 0; --j) {
          const int key = cb + kt * 16 + quad * 4 + j;
          const float z = st[kt][c][j];
          const float a = (key < t) ? fexp(z + lk[kt][j] + base + ex) : 0.f;
          st[kt][c][j] = a;
          ex += lk[kt][j];
        }
        run += tot[kt];
      }
      carry[c] = run;
    }
    bf16x8 pb[2][2];
#pragma unroll
    for (int c = 0; c < 2; ++c)
#pragma unroll
      for (int g = 0; g < 2; ++g)
        pb[c][g] = pack8(st[2 * g][c][0], st[2 * g][c][1], st[2 * g][c][2], st[2 * g][c][3],
                         st[2 * g + 1][c][0], st[2 * g + 1][c][1], st[2 * g + 1][c][2], st[2 * g + 1][c][3]);
#pragma unroll
    for (int g = 0; g < 2; ++g)
#pragma unroll
      for (int dt = 0; dt < 4; ++dt) {
        o[dt][0] = mfma16(vc[g][dt], pb[0][g], o[dt][0]);
        o[dt][1] = mfma16(vc[g][dt], pb[1][g], o[dt][1]);
      }
#pragma unroll
    for (int kt = 0; kt < 4; ++kt) { kc[kt][0] = kn[kt][0]; kc[kt][1] = kn[kt][1]; }
    if (__all((carry[0] < -104.f) && (carry[1] < -104.f))) break;
  }
  const float inv[2] = {1.f, 1.f};
  write_og4(p, o, inv, b, q0, 512 + h * 64, lane);
}

DEV int wave_sum_dpp(int v) {
  int x = v;
  x += __builtin_amdgcn_update_dpp(0, x, 0x111, 0xf, 0xf, false);
  x += __builtin_amdgcn_update_dpp(0, x, 0x112, 0xf, 0xf, false);
  x += __builtin_amdgcn_update_dpp(0, x, 0x114, 0xf, 0xf, false);
  x += __builtin_amdgcn_update_dpp(0, x, 0x118, 0xf, 0xf, false);
  x += __builtin_amdgcn_update_dpp(0, x, 0x142, 0xa, 0xf, false);
  x += __builtin_amdgcn_update_dpp(0, x, 0x143, 0xc, 0xf, false);
  return __builtin_amdgcn_readlane(x, 63);
}
DEV u16 key16(float s) { u16 u = f2bf(s); return (u & 0x8000u) ? (u16)(~u) : (u16)(u | 0x8000u); }

DEV void dsa_item(const Params& p, int b, int tile16, char* smem, int tid) {
  u16* keys = reinterpret_cast<u16*>(smem);
  u64* maskL = reinterpret_cast<u64*>(smem + 65536);
  const int wave = tid >> 6, lane = tid & 63, lr = lane & 15, quad = lane >> 4;
  const int t0 = tile16 * 16;
  const int nch = ((t0 + 15) >> 6) + 1;
  const size_t tb = (size_t)b * SEQ;
#if DBL == 10
  for (int half2 = 0; half2 < 4; ++half2) {
    const int half = half2 & 1;
#elif DBL == 12
  for (int half2 = 0; half2 < 2; ++half2) {
    const int half = half2;
#else
  for (int half = 0; half < 2; ++half) {
#endif
    const int qh0 = t0 + half * 8;
#if DBL == 12
    for (int rep = 0; rep < 2; ++rep)
#endif
    {
      bf16x8 ax[2], ay[2]; float wx[2][4], wy[2][4];
#pragma unroll
      for (int pr = 0; pr < 2; ++pr) {
        const int q = qh0 + pr * 4 + (lr >> 2);
        ax[pr] = ld8(P_IQ + ((tb + q) * 8 + (lr & 3)) * 32 + quad * 8);
        ay[pr] = ld8(P_IQ + ((tb + q) * 8 + 4 + (lr & 3)) * 32 + quad * 8);
        const int qo = qh0 + pr * 4 + quad;
        const float4 w0 = *reinterpret_cast<const float4*>(P_IW + (tb + qo) * 8);
        const float4 w1 = *reinterpret_cast<const float4*>(P_IW + (tb + qo) * 8 + 4);
        wx[pr][0] = w0.x; wx[pr][1] = w0.y; wx[pr][2] = w0.z; wx[pr][3] = w0.w;
        wy[pr][0] = w1.x; wy[pr][1] = w1.y; wy[pr][2] = w1.z; wy[pr][3] = w1.w;
      }
      for (int tile = wave; tile < ((nch + 1) >> 1) * 8; tile += 4) {
        const int key = tile * 16 + lr;
        const bf16x8 kf = ld8(P_IK + (tb + key) * 32 + quad * 8);
#pragma unroll
        for (int pr = 0; pr < 2; ++pr) {
          f32x4 X = mfma16(ax[pr], kf, f32x4{0.f, 0.f, 0.f, 0.f});
          f32x4 Y = mfma16(ay[pr], kf, f32x4{0.f, 0.f, 0.f, 0.f});
          float sc = 0.f;
#pragma unroll
          for (int j = 0; j < 4; ++j) { sc = fmaf(fmaxf(X[j], 0.f), wx[pr][j], sc); sc = fmaf(fmaxf(Y[j], 0.f), wy[pr][j], sc); }
          const int qo = qh0 + pr * 4 + quad;
          keys[(pr * 4 + quad) * 4096 + (key & ~127) + ((key & 63) << 1) + ((key >> 6) & 1)] = (key <= qo) ? key16(sc) : (u16)0;
        }
      }
    }
    __syncthreads();
    {
      const int qiA = wave * 2, qiB = wave * 2 + 1;
      const unsigned* kpA = reinterpret_cast<const unsigned*>(keys + qiA * 4096) + lane;
      const unsigned* kpB = reinterpret_cast<const unsigned*>(keys + qiB * 4096) + lane;
      const int nrd = (nch + 1) >> 1;
      unsigned TA = 0u, TB = 0u;
      for (int bit = 15; bit >= 0; --bit) {
        const unsigned cA = TA | (1u << bit), cB = TB | (1u << bit);
        int nA = 0, nB = 0;
#pragma unroll 4
        for (int r = 0; r < nrd; ++r) {
          const unsigned ka = kpA[r * 64], kb = kpB[r * 64];
          nA += ((ka & 0xFFFFu) >= cA) + ((ka >> 16) >= cA);
          nB += ((kb & 0xFFFFu) >= cB) + ((kb >> 16) >= cB);
        }
        const int pk = wave_sum_dpp(nA | (nB << 16));
        if ((pk & 0xFFFF) >= 256) TA = cA;
        if ((pk >> 16) >= 256) TB = cB;
      }
#pragma unroll
      for (int qq = 0; qq < 2; ++qq) {
        const unsigned T = qq ? TB : TA;
        const unsigned* kp = qq ? kpB : kpA;
        const int qi = wave * 2 + qq;
        int gl = 0;
#pragma unroll 4
        for (int r = 0; r < nrd; ++r) { const unsigned kv = kp[r * 64]; gl += ((kv & 0xFFFFu) > T) + ((kv >> 16) > T); }
        gl = wave_sum_dpp(gl);
        const int need = (T > 0u) ? (256 - gl) : 0;
        int running = 0;
        const u64 lt_mask = (lane == 0) ? 0ull : (~0ull >> (64 - lane));
        for (int r = 0; r < nrd; ++r) {
          const unsigned kv = kp[r * 64];
#pragma unroll
          for (int hf = 0; hf < 2; ++hf) {
            const unsigned kk = hf ? (kv >> 16) : (kv & 0xFFFFu);
            const bool eq = (T > 0u) && (kk == T);
            const u64 beq = __ballot(eq);
            const int rank = running + __popcll(beq & lt_mask);
            const bool sel = (kk > T) || (eq && rank < need);
            const u64 msk = __ballot(sel);
            running += __popcll(beq);
            if (lane == 0) maskL[(half * 8 + qi) * 64 + r * 2 + hf] = msk;
          }
        }
      }
    }
    __syncthreads();
  }
  {
    char* gbuf = smem + wave * 10752;
    u16* idxL = reinterpret_cast<u16*>(smem + 43008 + wave * 1088);
    unsigned char* flL = reinterpret_cast<unsigned char*>(smem + 47360 + wave * 544);
    const u64 lt_mask2 = (lane == 0) ? 0ull : (~0ull >> (64 - lane));
    const unsigned trbase = (unsigned)(size_t)gbuf + (unsigned)((quad * 4 + ((lane & 15) >> 2)) * 336 + (lane & 3) * 8);
    for (int pp = 0; pp < 2; ++pp) {
      const int pair = wave * 2 + pp;
      int n = 0;
      for (int ch = 0; ch < nch; ++ch) {
        const u64 ma = maskL[(pair * 2) * 64 + ch], mb = maskL[(pair * 2 + 1) * 64 + ch];
        const u64 u = ma | mb;
        if (u == 0ull) continue;
        if ((u >> lane) & 1ull) {
          const int pos = n + __popcll(u & lt_mask2);
          idxL[pos] = (u16)(ch * 64 + lane);
          flL[pos] = (unsigned char)(((ma >> lane) & 1ull) | (((mb >> lane) & 1ull) << 1));
        }
        n += __popcll(u);
      }
      const int npad = (n + 31) & ~31;
      if (lane < npad - n) { idxL[n + lane] = 0; flL[n + lane] = 0; }
      const int ngr = npad >> 5;
      bf16x8 qf[5];
#pragma unroll
      for (int ks = 0; ks < 5; ++ks) qf[ks] = ld8(P_QC + ((tb + t0 + pair * 2 + (lr >> 3)) * 8 + (lr & 7)) * 160 + ks * 32 + quad * 8);
      float m = NEG_INF, l = 0.f;
      f32x4 o[8];
#pragma unroll
      for (int dt = 0; dt < 8; ++dt) o[dt] = f32x4{0.f, 0.f, 0.f, 0.f};
      const int qsel = lr >> 3;
      uint4 gv0, gv1, gv2, gv3, gv4, gv5, gv6, gv7, gv8, gv9;
#define GLOAD(I, G) do { const int pc_ = lane + 64 * (I); const int slot_ = pc_ / 20, piece_ = pc_ - slot_ * 20; \
        const int key_ = idxL[(G) * 32 + slot_]; gv##I = *reinterpret_cast<const uint4*>(P_KVC + (tb + key_) * 160 + piece_ * 8); } while (0)
#define GSTORE(I) do { const int pc_ = lane + 64 * (I); const int slot_ = pc_ / 20, piece_ = pc_ - slot_ * 20; \
        *reinterpret_cast<uint4*>(gbuf + slot_ * 336 + piece_ * 16) = gv##I; } while (0)
      if (ngr > 0) { GLOAD(0, 0); GLOAD(1, 0); GLOAD(2, 0); GLOAD(3, 0); GLOAD(4, 0); GLOAD(5, 0); GLOAD(6, 0); GLOAD(7, 0); GLOAD(8, 0); GLOAD(9, 0); }
      else { gv0 = gv1 = gv2 = gv3 = gv4 = gv5 = gv6 = gv7 = gv8 = gv9 = make_uint4(0u, 0u, 0u, 0u); }
      for (int g = 0; g < ngr; ++g) {
        GSTORE(0); GSTORE(1); GSTORE(2); GSTORE(3); GSTORE(4); GSTORE(5); GSTORE(6); GSTORE(7); GSTORE(8); GSTORE(9);
        if (g + 1 < ngr) { GLOAD(0, g + 1); GLOAD(1, g + 1); GLOAD(2, g + 1); GLOAD(3, g + 1); GLOAD(4, g + 1); GLOAD(5, g + 1); GLOAD(6, g + 1); GLOAD(7, g + 1); GLOAD(8, g + 1); GLOAD(9, g + 1); }
        f32x4 st[2];
#pragma unroll
        for (int kt = 0; kt < 2; ++kt) {
          st[kt] = f32x4{0.f, 0.f, 0.f, 0.f};
#pragma unroll
          for (int ks = 0; ks < 5; ++ks) {
            bf16x8 kf = *reinterpret_cast<const bf16x8*>(gbuf + (kt * 16 + lr) * 336 + ks * 64 + quad * 16);
            st[kt] = mfma16(kf, qf[ks], st[kt]);
          }
        }
        float cm = NEG_INF;
#pragma unroll
        for (int kt = 0; kt < 2; ++kt) {
          const unsigned fw = *reinterpret_cast<const unsigned*>(flL + g * 32 + kt * 16 + quad * 4);
#pragma unroll
          for (int j = 0; j < 4; ++j) {
            const bool v = ((fw >> (8 * j + qsel)) & 1u) != 0u;
            const float sv = v ? st[kt][j] : NEG_INF;
            st[kt][j] = sv; cm = fmaxf(cm, sv);
          }
        }
        cm = xq_max(cm);
        if (!__all(cm <= m + 8.f)) {
          const float mn = fmaxf(m, cm);
          const float msn = (mn == NEG_INF) ? 0.f : mn;
          const float alpha = fexp2(m - msn);
          m = mn;
          l *= alpha;
#pragma unroll
          for (int dt = 0; dt < 8; ++dt) { o[dt][0] *= alpha; o[dt][1] *= alpha; o[dt][2] *= alpha; o[dt][3] *= alpha; }
        }
        const float ms = (m == NEG_INF) ? 0.f : m;
        float ps = 0.f;
#pragma unroll
        for (int kt = 0; kt < 2; ++kt)
#pragma unroll
          for (int j = 0; j < 4; ++j) { const float pv = fexp2(st[kt][j] - ms); st[kt][j] = pv; ps += pv; }
        l += ps;
        const bf16x8 pb = pack8(st[0][0], st[0][1], st[0][2], st[0][3], st[1][0], st[1][1], st[1][2], st[1][3]);
        uint2 ta[8], tc[8];
        asm volatile(
            "s_waitcnt lgkmcnt(0)\n\t"
            "ds_read_b64_tr_b16 %0, %16\n\t"
            "ds_read_b64_tr_b16 %1, %16 offset:32\n\t"
            "ds_read_b64_tr_b16 %2, %16 offset:64\n\t"
            "ds_read_b64_tr_b16 %3, %16 offset:96\n\t"
            "ds_read_b64_tr_b16 %4, %16 offset:128\n\t"
            "ds_read_b64_tr_b16 %5, %16 offset:160\n\t"
            "ds_read_b64_tr_b16 %6, %16 offset:192\n\t"
            "ds_read_b64_tr_b16 %7, %16 offset:224\n\t"
            "ds_read_b64_tr_b16 %8, %16 offset:5376\n\t"
            "ds_read_b64_tr_b16 %9, %16 offset:5408\n\t"
            "ds_read_b64_tr_b16 %10, %16 offset:5440\n\t"
            "ds_read_b64_tr_b16 %11, %16 offset:5472\n\t"
            "ds_read_b64_tr_b16 %12, %16 offset:5504\n\t"
            "ds_read_b64_tr_b16 %13, %16 offset:5536\n\t"
            "ds_read_b64_tr_b16 %14, %16 offset:5568\n\t"
            "ds_read_b64_tr_b16 %15, %16 offset:5600\n\t"
            "s_waitcnt lgkmcnt(0)"
            : "=&v"(ta[0]), "=&v"(ta[1]), "=&v"(ta[2]), "=&v"(ta[3]), "=&v"(ta[4]), "=&v"(ta[5]), "=&v"(ta[6]), "=&v"(ta[7]),
              "=&v"(tc[0]), "=&v"(tc[1]), "=&v"(tc[2]), "=&v"(tc[3]), "=&v"(tc[4]), "=&v"(tc[5]), "=&v"(tc[6]), "=&v"(tc[7])
            : "v"(trbase)
            : "memory");
#pragma unroll
        for (int dt = 0; dt < 8; ++dt) {
          union { bf16x8 v; unsigned u[4]; } vf;
          vf.u[0] = ta[dt].x; vf.u[1] = ta[dt].y; vf.u[2] = tc[dt].x; vf.u[3] = tc[dt].y;
          o[dt] = mfma16(vf.v, pb, o[dt]);
        }
      }
      const float inv = 1.f / quad_sum(l);
      u16* op = P_OLAT + ((tb + t0 + pair * 2 + qsel) * 8 + (lr & 7)) * 128 + quad * 4;
#pragma unroll
      for (int dt = 0; dt < 8; ++dt) st8b(op + dt * 16, o[dt][0] * inv, o[dt][1] * inv, o[dt][2] * inv, o[dt][3] * inv);
    }
  }
  __threadfence_block();
  __syncthreads();
#pragma unroll
  for (int c = 0; c < 2; ++c) {
    const int h = wave * 2 + c;
    f32x4 res[4];
#pragma unroll
    for (int dvt = 0; dvt < 4; ++dvt) res[dvt] = f32x4{0.f, 0.f, 0.f, 0.f};
#pragma unroll
    for (int g = 0; g < 4; ++g) {
      const bf16x8 pbv = ld8(P_OLAT + ((tb + t0 + lr) * 8 + h) * 128 + g * 32 + quad * 8);
#pragma unroll
      for (int dvt = 0; dvt < 4; ++dvt) {
        const bf16x8 wf = ld8(P_WUVp + ((size_t)(h * 64 + dvt * 16 + lr)) * 128 + g * 32 + quad * 8);
        res[dvt] = mfma16(wf, pbv, res[dvt]);
      }
    }
    const size_t base = (tb + t0 + lr) * 1024 + h * 64 + quad * 4;
#pragma unroll
    for (int dvt = 0; dvt < 4; ++dvt) {
      uint2 sg = *reinterpret_cast<const uint2*>(P_SG + base + dvt * 16);
      float g0 = bf2f((u16)(sg.x & 0xFFFF)), g1 = bf2f((u16)(sg.x >> 16)), g2 = bf2f((u16)(sg.y & 0xFFFF)), g3 = bf2f((u16)(sg.y >> 16));
      st8b(P_OG + base + dvt * 16, res[dvt][0] * g0, res[dvt][1] * g1, res[dvt][2] * g2, res[dvt][3] * g3);
    }
  }
}

DEV void phase_attn(const Params& p, int layer, char* smem, int tid_in, int ctr_idx, int it_lo, int it_hi) {
  int* s_item = reinterpret_cast<int*>(smem + 73728);
  for (;;) {
    const int tid = opq(tid_in);
    const int wave = tid >> 6, lane = tid & 63;
    if (tid == 0) *s_item = atomicAdd(P_ctr + ctr_idx, 1);
    __syncthreads();
    const int it = *s_item + it_lo;
    __syncthreads();
    if (it >= it_hi) break;
    if (layer == 0) {
      if (it < 1024) { const int qt = 31 - (it >> 5), bh = it & 31; moba_item(p, bh >> 3, bh & 7, qt, wave, lane, smem); }
      else { const int i = it - 1024; const int t32 = i >> 3, bk = i & 7; swa_item(p, bk >> 1, bk & 1, t32, wave, lane, smem); }
    } else {
      if (it < 1024) { const int tile16 = 255 - (it >> 2), b = it & 3; dsa_item(p, b, tile16, smem, tid); }
      else { const int i = it - 1024; const int qt = i >> 5, bh = i & 31; sb_item(p, bh >> 3, bh & 7, qt, wave, lane); }
    }
  }
}

__global__ void __launch_bounds__(256, 2) fwd_megakernel(Params p) {
  __shared__ __attribute__((aligned(16))) char smem[73728 + 64];
  cg::grid_group grid = cg::this_grid();
  __shared__ uint4 xb_words;
  if (threadIdx.x == 0) xb_words = make_uint4(0u, 0u, 0u, 0u);
  __syncthreads();
  XcdBarrier xb = xcd_barrier_post(P_bar, (volatile LAS unsigned*)&xb_words);
  if (p.out == nullptr) grid.sync();
#define OPQ_TID() ({ int t_; asm volatile("v_mov_b32 %0, %1" : "=v"(t_) : "v"((int)threadIdx.x)); t_; })
#define GSYNC() xcd_barrier(xb)
#define VID() ((int)((volatile LAS unsigned*)&xb_words)[3])
  phase0(p, smem, OPQ_TID());
  GSYNC();
  phase_prep(p, 0, OPQ_TID());
  GSYNC();
  phase_inproj(p, 0, smem, OPQ_TID(), VID());
#if DBL == 1
  GSYNC(); phase_inproj(p, 0, smem, OPQ_TID(), VID());
#endif
  GSYNC();
  phase_attn(p, 0, smem, OPQ_TID(), 0, 0, 2048);
#if DBL == 2
  GSYNC(); phase_attn(p, 0, smem, OPQ_TID(), 2, 0, 1024);
#elif DBL == 7
  GSYNC(); phase_attn(p, 0, smem, OPQ_TID(), 2, 1024, 2048);
#endif
  GSYNC();
  phase_outproj(p, 0, smem, OPQ_TID(), VID());
#if DBL == 3
  GSYNC(); phase_outproj(p, 0, smem, OPQ_TID(), VID());
#endif
  GSYNC();
  phase_prep(p, 1, OPQ_TID());
  GSYNC();
  phase_inproj(p, 1, smem, OPQ_TID(), VID());
#if DBL == 4
  GSYNC(); phase_inproj(p, 1, smem, OPQ_TID(), VID());
#endif
  GSYNC();
  phase_attn(p, 1, smem, OPQ_TID(), 1, 0, 2048);
#if DBL == 5
  GSYNC(); phase_attn(p, 1, smem, OPQ_TID(), 3, 0, 1024);
#elif DBL == 6
  GSYNC(); phase_attn(p, 1, smem, OPQ_TID(), 3, 1024, 2048);
#endif
  GSYNC();
  phase_outproj(p, 1, smem, OPQ_TID(), VID());
  GSYNC();
  phase_final_ln(p, OPQ_TID());
}

extern "C" void kernel_launch(void* const* d_in, const int* in_sizes, int n_in, void* d_out, int out_size,
                              void* d_ws, size_t ws_size, hipStream_t stream) {
  static int grid_blocks = 0;
  if (!grid_blocks) {
    int dev = 0, cus = 0, per_cu = 0;
    hipGetDevice(&dev);
    hipDeviceGetAttribute(&cus, hipDeviceAttributeMultiprocessorCount, dev);
    hipOccupancyMaxActiveBlocksPerMultiprocessor(&per_cu, fwd_megakernel, 256, 0);
    if (per_cu < 1) per_cu = 1;
    if (per_cu > 2) per_cu = 2;
    grid_blocks = cus * per_cu;
  }
  Params p{};
  p.x = (const float*)d_in[0]; p.c = (const float*)d_in[1]; p.w_ada = (const float*)d_in[2]; p.b_ada = (const float*)d_in[3];
  p.w_in_even = (const float*)d_in[4]; p.sinks = (const float*)d_in[5]; p.w_in_odd = (const float*)d_in[6]; p.kvg = (const float*)d_in[7];
  p.w_uk = (const float*)d_in[8]; p.w_uv = (const float*)d_in[9]; p.w_out = (const float*)d_in[10]; p.ln_g = (const float*)d_in[11]; p.ln_b = (const float*)d_in[12];
  p.out = (float*)d_out;
  p.ws = (char*)d_ws;
  if (WS_NEEDED > ws_size) { fprintf(stderr, "workspace too small: need %zu have %zu\n", (size_t)WS_NEEDED, ws_size); return; }
  hipMemsetAsync(p.ws + 24871168ull, 0, (size_t)XCD_BAR_WORDS * 4, stream);
  void* args[] = {&p};
  hipError_t e = hipLaunchCooperativeKernel((void*)fwd_megakernel, dim3(grid_blocks), dim3(256), args, 0, stream);
  if (e != hipSuccess) fprintf(stderr, "cooperative launch failed: %s (grid %d)\n", hipGetErrorString(e), grid_blocks);
}
```

```cpp
#include <hip/hip_runtime.h>
#include <hip/hip_cooperative_groups.h>
#include <cstdio>
namespace cg = cooperative_groups;

typedef unsigned short u16;
typedef unsigned long long u64;
typedef __attribute__((ext_vector_type(8))) short bf16x8;
typedef __attribute__((ext_vector_type(4))) float f32x4;

#define DBL 0
#define DEV __device__ __forceinline__
#define NEG_INF (-__builtin_inff())

static constexpr int SEQ = 4096;
static constexpr int NTOK = 16384;
static constexpr int DM = 1024;
static constexpr int EVEN_IN = 3328;
static constexpr int ODD_IN = 3784;
static constexpr int ODD_N = 4352;
static constexpr float LOG2E = 1.4426950408889634f;
static constexpr float LN_EPS = 1e-5f;
static constexpr float DN_ALPHA = 1.4142135623730951f;

struct Params {
  const float *x, *c, *w_ada, *b_ada, *w_in_even, *sinks, *w_in_odd, *kvg, *w_uk, *w_uv, *w_out, *ln_g, *ln_b;
  float* out;
  char* ws;
};
#define P_WTe (reinterpret_cast<u16*>(p.ws + 0ull))
#define P_WTo (reinterpret_cast<u16*>(p.ws + 6815744ull))
#define P_WOT (reinterpret_cast<u16*>(p.ws + 15728640ull))
#define P_WUVp (reinterpret_cast<u16*>(p.ws + 19922944ull))
#define P_mods (reinterpret_cast<float*>(p.ws + 20054016ull))
#define P_cos64 (reinterpret_cast<float*>(p.ws + 20152320ull))
#define P_sin64 (reinterpret_cast<float*>(p.ws + 20676608ull))
#define P_cos32 (reinterpret_cast<float*>(p.ws + 21200896ull))
#define P_sin32 (reinterpret_cast<float*>(p.ws + 21463040ull))
#define P_kpart (reinterpret_cast<float*>(p.ws + 21725184ull))
#define P_stats0 (reinterpret_cast<float*>(p.ws + 22249472ull))
#define P_stats1 (reinterpret_cast<float*>(p.ws + 23298048ull))
#define P_IW (reinterpret_cast<float*>(p.ws + 24346624ull))
#define P_ctr (reinterpret_cast<int*>(p.ws + 24870912ull))
#define P_bar (reinterpret_cast<unsigned*>(p.ws + 24871168ull))
#define P_SG (reinterpret_cast<u16*>(p.ws + 24884992ull))
#define P_OG (reinterpret_cast<u16*>(p.ws + 58439424ull))
#define P_AQ (reinterpret_cast<u16*>(p.ws + 91993856ull))
#define P_AK (reinterpret_cast<u16*>(p.ws + 108771072ull))
#define P_AVt (reinterpret_cast<u16*>(p.ws + 125548288ull))
#define P_BQ (reinterpret_cast<u16*>(p.ws + 142325504ull))
#define P_BKk (reinterpret_cast<u16*>(p.ws + 159102720ull))
#define P_BVt (reinterpret_cast<u16*>(p.ws + 163297024ull))
#define P_QC (reinterpret_cast<u16*>(p.ws + 91993856ull))
#define P_V1B (reinterpret_cast<u16*>(p.ws + 91993856ull))
#define P_KVC (reinterpret_cast<u16*>(p.ws + 133936896ull))
#define P_CKVt (reinterpret_cast<u16*>(p.ws + 139179776ull))
#define P_IQ (reinterpret_cast<u16*>(p.ws + 143374080ull))
#define P_IK (reinterpret_cast<u16*>(p.ws + 151762688ull))
#define P_DQ (reinterpret_cast<u16*>(p.ws + 152811264ull))
#define P_DK (reinterpret_cast<u16*>(p.ws + 169588480ull))
#define P_DVt (reinterpret_cast<u16*>(p.ws + 186365696ull))
#define P_OLAT (reinterpret_cast<u16*>(p.ws + 203142912ull))
#define P_H (reinterpret_cast<u16*>(p.ws + 203142912ull))
static constexpr size_t WS_NEEDED = 236697344ull;

DEV int opq(int x) { asm volatile("" : "+v"(x)); return x; }
DEV u16 f2bf(float f) { unsigned u = __float_as_uint(f); u += 0x7FFFu + ((u >> 16) & 1u); return (u16)(u >> 16); }
DEV float bf2f(u16 h) { return __uint_as_float(((unsigned)h) << 16); }
DEV unsigned pack2(float a, float b) { unsigned r; asm("v_cvt_pk_bf16_f32 %0, %1, %2" : "=v"(r) : "v"(a), "v"(b)); return r; }
DEV bf16x8 pack8(float a0, float a1, float a2, float a3, float a4, float a5, float a6, float a7) {
  union { bf16x8 v; unsigned u[4]; } r;
  r.u[0] = pack2(a0, a1); r.u[1] = pack2(a2, a3); r.u[2] = pack2(a4, a5); r.u[3] = pack2(a6, a7);
  return r.v;
}
DEV bf16x8 ld8(const u16* p) { return *reinterpret_cast<const bf16x8*>(p); }
DEV f32x4 mfma16(bf16x8 a, bf16x8 b, f32x4 c) { return __builtin_amdgcn_mfma_f32_16x16x32_bf16(a, b, c, 0, 0, 0); }
DEV float fexp2(float x) { return __builtin_amdgcn_exp2f(x); }
DEV float fexp(float x) { return __builtin_amdgcn_exp2f(x * LOG2E); }
DEV float flog(float x) { return __builtin_amdgcn_logf(x) * 0.6931471805599453f; }
DEV float silu_f(float x) { return x / (1.f + fexp(-x)); }
DEV void st8b(u16* p, float a, float b, float c, float d) { uint2 v; v.x = pack2(a, b); v.y = pack2(c, d); *reinterpret_cast<uint2*>(p) = v; }
DEV void st16b(u16* p, const float* v) { uint4 u; u.x = pack2(v[0], v[1]); u.y = pack2(v[2], v[3]); u.z = pack2(v[4], v[5]); u.w = pack2(v[6], v[7]); *reinterpret_cast<uint4*>(p) = u; }


#define XB_TMO      128
#define XB_XCNT(j)  (256  + 64 * (j))
#define XB_XSUB(j)  (1280 + 64 * (j))
#define XB_XGEN(j)  (2304 + 64 * (j))
#define XB_TOP      3328
#define XB_TOPGEN   3392
#define XCD_BAR_WORDS 3456
#define XB_SPIN_CAP (1u << 18)
#define LAS __attribute__((address_space(3)))
DEV unsigned xb_ld(unsigned* p)              { return __hip_atomic_load(p, __ATOMIC_RELAXED, __HIP_MEMORY_SCOPE_AGENT); }
DEV unsigned xb_add(unsigned* p, unsigned v) { return __hip_atomic_fetch_add(p, v, __ATOMIC_RELAXED, __HIP_MEMORY_SCOPE_AGENT); }
DEV unsigned xb_xcc_id() { return (unsigned)__builtin_amdgcn_s_getreg((3 << 11) | 20) & 0xFu; }
#define XB_SPIN(cond, bar) do { unsigned _sp = 0; while (cond) { __builtin_amdgcn_s_sleep(1); \
    if ((++_sp & 255u) == 0u) { if (xb_ld(&(bar)[XB_TMO])) break; if (_sp > XB_SPIN_CAP) { atomicAdd(&(bar)[XB_TMO], 1u); break; } } } } while (0)
struct XcdBarrier { unsigned* bar; unsigned x; volatile LAS unsigned* st; };
DEV XcdBarrier xcd_barrier_post(unsigned* bar, volatile LAS unsigned* st) {
  XcdBarrier b; b.bar = bar; b.x = xb_xcc_id(); b.st = st;
  if (threadIdx.x == 0) st[2] = xb_add(&bar[XB_XCNT(b.x)], 1u);
  return b;
}
DEV void xcd_barrier_complete(unsigned* bar, unsigned x, unsigned& nloc, unsigned& nx, unsigned& before) {
  const unsigned G = gridDim.x * gridDim.y * gridDim.z;
  unsigned sum, cnt, mine, bef, sp = 0u;
  for (;;) {
    sum = 0u; cnt = 0u; mine = 0u; bef = 0u;
#pragma unroll
    for (unsigned j = 0; j < 16; ++j) { const unsigned c = xb_ld(&bar[XB_XCNT(j)]); sum += c; cnt += (c > 0u) ? 1u : 0u; mine = (j == x) ? c : mine; bef += (j < x) ? c : 0u; }
    if (sum == G) break;
    __builtin_amdgcn_s_sleep(1);
    if ((++sp & 255u) == 0u) { if (xb_ld(&bar[XB_TMO])) break; if (sp > XB_SPIN_CAP) { atomicAdd(&bar[XB_TMO], 1u); break; } }
  }
  nloc = mine > 0u ? mine : 1u; nx = cnt > 0u ? cnt : 1u; before = bef;
}
DEV void xcd_barrier(const XcdBarrier& b) {
  asm volatile("s_waitcnt vmcnt(0)" ::: "memory");
  __syncthreads();
  if (threadIdx.x == 0) {
    unsigned* bar = b.bar;
    __builtin_amdgcn_s_waitcnt(0);
    unsigned nloc = b.st[0], nx = b.st[1];
    if (nloc == 0u) { unsigned bef; xcd_barrier_complete(bar, b.x, nloc, nx, bef); b.st[0] = nloc; b.st[1] = nx; b.st[3] = bef + b.st[2]; }
    const unsigned old = xb_add(&bar[XB_XSUB(b.x)], 1u);
    const unsigned gen = old / nloc;
    if (old + 1u == (gen + 1u) * nloc) {
      __builtin_amdgcn_fence(__ATOMIC_RELEASE, "agent");
      asm volatile("s_waitcnt vmcnt(0)" ::: "memory");
      const unsigned og = xb_add(&bar[XB_TOP], 1u);
      const unsigned tg = og / nx;
      if (og + 1u == (tg + 1u) * nx) xb_add(&bar[XB_TOPGEN], 1u);
      else XB_SPIN(xb_ld(&bar[XB_TOPGEN]) == tg, bar);
      __builtin_amdgcn_fence(__ATOMIC_ACQUIRE, "agent");
      xb_add(&bar[XB_XGEN(b.x)], 1u);
      asm volatile("s_waitcnt vmcnt(0)" ::: "memory");
    } else {
      XB_SPIN(xb_ld(&bar[XB_XGEN(b.x)]) == gen, bar);
      __builtin_amdgcn_fence(__ATOMIC_ACQUIRE, "agent");
      asm volatile("s_waitcnt vmcnt(0)" ::: "memory");
    }
  }
  __syncthreads();
}

DEV int odd_srccol(int n) {
  if (n < 1024) return -1;
  if (n < 1280) return 512 + (n - 1024);
  if (n < 1408) return 768 + (n - 1280);
  if (n < 1536) { int j = n - 1408; if (j < 32) return 896 + j; if (j < 64) return 1184 + (j - 32); if (j < 72) return 1216 + (j - 64); return -1; }
  if (n < 1792) return 928 + (n - 1536);
  if (n < 3328) return 1224 + (n - 1792);
  return 2760 + (n - 3328);
}

DEV void p0_transpose(const float* __restrict__ src, int ld, int mapmode, u16* __restrict__ dst, int n0, int k0, float* tile, int tid) {
  const int n = tid & 63;
  const int dn = n0 + n;
  const int sc = mapmode ? odd_srccol(dn) : dn;
#pragma unroll
  for (int i = 0; i < 16; ++i) {
    int kr = (tid >> 6) + 4 * i;
    tile[kr * 65 + n] = (sc >= 0) ? src[(size_t)(k0 + kr) * ld + sc] : 0.f;
  }
  __syncthreads();
#pragma unroll
  for (int i = 0; i < 16; ++i) {
    int nr = (tid >> 6) + 4 * i;
    int k = tid & 63;
    dst[(size_t)(n0 + nr) * 1024 + k0 + k] = f2bf(tile[k * 65 + nr]);
  }
  __syncthreads();
}

DEV void phase0(const Params& p, char* smem, int tid_in) {
  float* fs = reinterpret_cast<float*>(smem);
  const int NITEM = 96 + 512 + 2176 + 64;
  for (int it = blockIdx.x; it < NITEM; it += gridDim.x) {
    const int tid = opq(tid_in);
    if (it < 96) {
      const int col0 = it * 64; const int l = col0 / 3072; const int n0 = col0 % 3072;
      float* sc = fs;
      float* red = fs + 4096;
      for (int e = tid; e < 4096; e += 256) sc[e] = silu_f(p.c[e]);
      __syncthreads();
      const int cgp = tid & 15, ks = tid >> 4;
      float acc[4][4];
#pragma unroll
      for (int b = 0; b < 4; ++b) for (int e = 0; e < 4; ++e) acc[b][e] = 0.f;
      const float* wp = p.w_ada + ((size_t)l * 1024 + ks * 64) * 3072 + n0 + cgp * 4;
#pragma unroll 8
      for (int k = 0; k < 64; ++k) {
        float4 w = *reinterpret_cast<const float4*>(wp + (size_t)k * 3072);
#pragma unroll
        for (int b = 0; b < 4; ++b) {
          float s = sc[b * 1024 + ks * 64 + k];
          acc[b][0] += s * w.x; acc[b][1] += s * w.y; acc[b][2] += s * w.z; acc[b][3] += s * w.w;
        }
      }
#pragma unroll
      for (int b = 0; b < 4; ++b) for (int e = 0; e < 4; ++e) red[(ks * 4 + b) * 64 + cgp * 4 + e] = acc[b][e];
      __syncthreads();
      {
        const int b = tid >> 6, n = tid & 63;
        float s = 0.f;
#pragma unroll
        for (int k2 = 0; k2 < 16; ++k2) s += red[(k2 * 4 + b) * 64 + n];
        P_mods[(size_t)(l * 4 + b) * 3072 + n0 + n] = s + p.b_ada[l * 3072 + n0 + n];
      }
      __syncthreads();
    } else if (it < 608) {
      const int i = it - 96; const int h = i >> 6; const int k0 = ((i >> 2) & 15) * 64; const int cq = i & 3;
      float* Wk = fs;
#pragma unroll
      for (int r = 0; r < 16; ++r) {
        int kk = (tid >> 6) + 4 * r; int d = tid & 63;
        Wk[kk * 65 + d] = p.w_in_odd[(size_t)(k0 + kk) * ODD_IN + h * 64 + d];
      }
      __syncthreads();
      const int kk = tid & 63; const int cgp = tid >> 6;
      float wk[64];
#pragma unroll
      for (int d = 0; d < 64; ++d) wk[d] = Wk[kk * 65 + d];
#pragma unroll 2
      for (int cc = 0; cc < 8; ++cc) {
        const int cidx = cq * 32 + cgp * 8 + cc;
        const float* uk = p.w_uk + ((size_t)(h * 128 + cidx)) * 64;
        float a = 0.f;
#pragma unroll
        for (int d = 0; d < 64; ++d) a += wk[d] * uk[d];
        P_WTo[(size_t)(h * 128 + cidx) * 1024 + k0 + kk] = f2bf(a);
      }
      __syncthreads();
    } else if (it < 608 + 2176) {
      const int i = it - 608;
      if (i < 832) { p0_transpose(p.w_in_even, EVEN_IN, 0, P_WTe, (i >> 4) * 64, (i & 15) * 64, fs, tid); }
      else if (i < 1664) { int j = i - 832; p0_transpose(p.w_in_odd, ODD_IN, 1, P_WTo, 1024 + (j >> 4) * 64, (j & 15) * 64, fs, tid); }
      else { int j = i - 1664; int l = j >> 8; int jj = j & 255; p0_transpose(p.w_out + (size_t)l * 1024 * 1024, 1024, 0, P_WOT + (size_t)l * 1024 * 1024, (jj >> 4) * 64, (jj & 15) * 64, fs, tid); }
    } else {
      const int i = it - 2784;
      const int gtid = i * 256 + tid; const int gstr = 64 * 256;
      if (gtid == 0) { P_ctr[0] = 0; P_ctr[1] = 0; P_ctr[2] = 0; P_ctr[3] = 0; }
      for (int e = gtid; e < 4096 * 32; e += gstr) {
        int pos = e >> 5, f = e & 31;
        float inv = 1.0f / powf(10000.f, (float)(2 * f) / 64.f);
        float ang = (float)pos * inv;
        double rev = (double)ang * 0.15915494309189535; rev -= floor(rev);
        float fr = (float)rev;
        P_cos64[e] = __builtin_amdgcn_cosf(fr); P_sin64[e] = __builtin_amdgcn_sinf(fr);
      }
      for (int e = gtid; e < 4096 * 16; e += gstr) {
        int pos = e >> 4, f = e & 15;
        float inv = 1.0f / powf(10000.f, (float)(2 * f) / 32.f);
        float ang = (float)pos * inv;
        double rev = (double)ang * 0.15915494309189535; rev -= floor(rev);
        float fr = (float)rev;
        P_cos32[e] = __builtin_amdgcn_cosf(fr); P_sin32[e] = __builtin_amdgcn_sinf(fr);
      }
      for (int e = gtid; e < 8 * 128 * 64; e += gstr) {
        int cidx = e & 127, dv = (e >> 7) & 63, h = e >> 13;
        P_WUVp[e] = f2bf(p.w_uv[((size_t)(h * 128 + cidx)) * 64 + dv]);
      }
    }
  }
}

static constexpr int LDA_S = 72;
static constexpr int CS_LD = 132;
static constexpr int ROWSTAT_OFF = 67584;

DEV float4 ld4bf(const u16* p) { const uint2 vb = *reinterpret_cast<const uint2*>(p); float4 v; v.x = bf2f((u16)(vb.x & 0xFFFF)); v.y = bf2f((u16)(vb.x >> 16)); v.z = bf2f((u16)(vb.y & 0xFFFF)); v.w = bf2f((u16)(vb.y >> 16)); return v; }
DEV void row_stats_from_partials(const float* __restrict__ stats, int row, float& mu, float& rstd) {
  const float4* sp = reinterpret_cast<const float4*>(stats + (size_t)row * 16);
  float s = 0.f, ss = 0.f;
#pragma unroll
  for (int i = 0; i < 4; ++i) { float4 v = sp[i]; s += v.x + v.z; ss += v.y + v.w; }
  mu = s * (1.f / 1024.f);
  float var = ss * (1.f / 1024.f) - mu * mu;
  rstd = rsqrtf(fmaxf(var, 0.f) + LN_EPS);
}

template <bool AF32>
DEV void gemm_mainloop(const void* __restrict__ Aptr, const u16* __restrict__ Bt, int m0, int n0,
                       const float* __restrict__ lng, const float* __restrict__ lnb,
                       const float* __restrict__ msc, const float* __restrict__ msh,
                       const float* __restrict__ stats, char* smem, f32x4 (&acc)[4][4], int tid) {
  float* rowstat = reinterpret_cast<float*>(smem + ROWSTAT_OFF);
  const int wave = tid >> 6, lane = tid & 63, lr = lane & 15, quad = lane >> 4;
  const int wm = wave >> 1, wn = wave & 1;
#pragma unroll
  for (int i = 0; i < 4; ++i)
#pragma unroll
    for (int j = 0; j < 4; ++j) acc[i][j] = f32x4{0.f, 0.f, 0.f, 0.f};

  float rmu0 = 0.f, rmu1 = 0.f, rmu2 = 0.f, rmu3 = 0.f, rmu4 = 0.f, rmu5 = 0.f, rmu6 = 0.f, rmu7 = 0.f;
  float rrs0 = 1.f, rrs1 = 1.f, rrs2 = 1.f, rrs3 = 1.f, rrs4 = 1.f, rrs5 = 1.f, rrs6 = 1.f, rrs7 = 1.f;
  if (AF32) {
    if (tid < 128) {
      float mu = 0.f, rs = 1.f;
      if (stats) row_stats_from_partials(stats, m0 + tid, mu, rs);
      rowstat[tid * 2] = mu; rowstat[tid * 2 + 1] = rs;
    }
    __syncthreads();
#define RS_LD(I) { int r = (tid >> 4) + 16 * I; rmu##I = rowstat[r * 2]; rrs##I = rowstat[r * 2 + 1]; }
    RS_LD(0) RS_LD(1) RS_LD(2) RS_LD(3) RS_LD(4) RS_LD(5) RS_LD(6) RS_LD(7)
#undef RS_LD
  }

  uint4 b0, b1, b2, b3, a0, a1, a2, a3;
  float4 f0, f1, f2, f3, f4, f5, f6, f7;
  const int brow = tid >> 3, bpc = tid & 7;
  const u16* bsrc = Bt + (size_t)(n0 + brow) * 1024 + bpc * 8;
  const u16* asrc16 = reinterpret_cast<const u16*>(Aptr) + (size_t)(m0 + brow) * 1024 + bpc * 8;
  const int acg = tid & 15, arow = tid >> 4;
  const float* asrc32 = reinterpret_cast<const float*>(Aptr) + (size_t)(m0 + arow) * 1024 + acg * 4;
  const int bst = brow * 128 + ((bpc ^ ((brow >> 1) & 7)) << 4);
  const int ast = arow * 128 + ((((acg >> 1) ^ ((arow >> 1) & 7))) << 4) + (acg & 1) * 8;
  const int fsw = (lr >> 1) & 7;
  const int ard = (wm * 64 + lr) * 128, brd = 16384 + (wn * 64 + lr) * 128;
  const int fo0 = ((quad ^ fsw) << 4), fo1 = (((4 + quad) ^ fsw) << 4);

#define GEMM_LOAD_TILE(KT) do { const int k0_ = (KT) * 64; \
    b0 = *reinterpret_cast<const uint4*>(bsrc + k0_); b1 = *reinterpret_cast<const uint4*>(bsrc + k0_ + 32 * 1024); \
    b2 = *reinterpret_cast<const uint4*>(bsrc + k0_ + 64 * 1024); b3 = *reinterpret_cast<const uint4*>(bsrc + k0_ + 96 * 1024); \
    if (AF32) { \
      f0 = *reinterpret_cast<const float4*>(asrc32 + (size_t)(0) * 1024 + k0_);  f1 = *reinterpret_cast<const float4*>(asrc32 + (size_t)(16) * 1024 + k0_); \
      f2 = *reinterpret_cast<const float4*>(asrc32 + (size_t)(32) * 1024 + k0_); f3 = *reinterpret_cast<const float4*>(asrc32 + (size_t)(48) * 1024 + k0_); \
      f4 = *reinterpret_cast<const float4*>(asrc32 + (size_t)(64) * 1024 + k0_); f5 = *reinterpret_cast<const float4*>(asrc32 + (size_t)(80) * 1024 + k0_); \
      f6 = *reinterpret_cast<const float4*>(asrc32 + (size_t)(96) * 1024 + k0_); f7 = *reinterpret_cast<const float4*>(asrc32 + (size_t)(112) * 1024 + k0_); \
    } else { \
      a0 = *reinterpret_cast<const uint4*>(asrc16 + k0_); a1 = *reinterpret_cast<const uint4*>(asrc16 + k0_ + 32 * 1024); \
      a2 = *reinterpret_cast<const uint4*>(asrc16 + k0_ + 64 * 1024); a3 = *reinterpret_cast<const uint4*>(asrc16 + k0_ + 96 * 1024); \
    } } while (0)
#define GEMM_AFF(FV, I) do { \
    float q0_ = ((FV).x - rmu##I) * rrs##I * G.x + Bv.x; float q1_ = ((FV).y - rmu##I) * rrs##I * G.y + Bv.y; \
    float q2_ = ((FV).z - rmu##I) * rrs##I * G.z + Bv.z; float q3_ = ((FV).w - rmu##I) * rrs##I * G.w + Bv.w; \
    uint2 pk_; pk_.x = pack2(q0_, q1_); pk_.y = pack2(q2_, q3_); \
    *reinterpret_cast<uint2*>(sb_ + ast + (I) * 2048) = pk_; } while (0)
#define GEMM_STORE_TILE(KT, STG) do { char* sb_ = smem + (STG) * 32768; \
      *reinterpret_cast<uint4*>(sb_ + 16384 + bst) = b0; *reinterpret_cast<uint4*>(sb_ + 16384 + bst + 4096) = b1; \
      *reinterpret_cast<uint4*>(sb_ + 16384 + bst + 8192) = b2; *reinterpret_cast<uint4*>(sb_ + 16384 + bst + 12288) = b3; \
      if (AF32) { \
        const int k = (KT) * 64 + acg * 4; \
        float4 sc = *reinterpret_cast<const float4*>(msc + k); \
        float4 sh = *reinterpret_cast<const float4*>(msh + k); \
        float4 G, Bv; \
        if (lng) { \
          float4 g = *reinterpret_cast<const float4*>(lng + k); \
          float4 bb = *reinterpret_cast<const float4*>(lnb + k); \
          G.x = g.x * (1.f + sc.x); G.y = g.y * (1.f + sc.y); G.z = g.z * (1.f + sc.z); G.w = g.w * (1.f + sc.w); \
          Bv.x = bb.x * (1.f + sc.x) + sh.x; Bv.y = bb.y * (1.f + sc.y) + sh.y; Bv.z = bb.z * (1.f + sc.z) + sh.z; Bv.w = bb.w * (1.f + sc.w) + sh.w; \
        } else { \
          G.x = 1.f + sc.x; G.y = 1.f + sc.y; G.z = 1.f + sc.z; G.w = 1.f + sc.w; \
          Bv = sh; \
        } \
        GEMM_AFF(f0, 0); GEMM_AFF(f1, 1); GEMM_AFF(f2, 2); GEMM_AFF(f3, 3); \
        GEMM_AFF(f4, 4); GEMM_AFF(f5, 5); GEMM_AFF(f6, 6); GEMM_AFF(f7, 7); \
      } else { \
        *reinterpret_cast<uint4*>(sb_ + bst) = a0; *reinterpret_cast<uint4*>(sb_ + bst + 4096) = a1; \
        *reinterpret_cast<uint4*>(sb_ + bst + 8192) = a2; *reinterpret_cast<uint4*>(sb_ + bst + 12288) = a3; \
      } } while (0)

  GEMM_LOAD_TILE(0);
  GEMM_STORE_TILE(0, 0);
  GEMM_LOAD_TILE(1);
  __syncthreads();
  for (int kt = 0; kt < 16; ++kt) {
    const int cur = kt & 1;
    if (kt + 1 < 16) GEMM_STORE_TILE(kt + 1, cur ^ 1);
    if (kt + 2 < 16) GEMM_LOAD_TILE(kt + 2);
    {
      const char* sb = smem + cur * 32768;
      bf16x8 af0[4], bf0[4], af1[4], bf1[4];
#pragma unroll
      for (int mi = 0; mi < 4; ++mi) af0[mi] = *reinterpret_cast<const bf16x8*>(sb + ard + mi * 2048 + fo0);
#pragma unroll
      for (int ni = 0; ni < 4; ++ni) bf0[ni] = *reinterpret_cast<const bf16x8*>(sb + brd + ni * 2048 + fo0);
#pragma unroll
      for (int mi = 0; mi < 4; ++mi) af1[mi] = *reinterpret_cast<const bf16x8*>(sb + ard + mi * 2048 + fo1);
#pragma unroll
      for (int ni = 0; ni < 4; ++ni) bf1[ni] = *reinterpret_cast<const bf16x8*>(sb + brd + ni * 2048 + fo1);
      __builtin_amdgcn_sched_barrier(0);
#pragma unroll
      for (int mi = 0; mi < 4; ++mi)
#pragma unroll
        for (int ni = 0; ni < 4; ++ni) acc[mi][ni] = mfma16(af0[mi], bf0[ni], acc[mi][ni]);
#pragma unroll
      for (int mi = 0; mi < 4; ++mi)
#pragma unroll
        for (int ni = 0; ni < 4; ++ni) acc[mi][ni] = mfma16(af1[mi], bf1[ni], acc[mi][ni]);
    }
    __syncthreads();
  }
}

DEV void stage_all(f32x4 (&acc)[4][4], float* Cs, int tid) {
  const int wave = tid >> 6, lane = tid & 63, lr = lane & 15, quad = lane >> 4;
  const int wm = wave >> 1, wn = wave & 1;
#pragma unroll
  for (int mi = 0; mi < 4; ++mi)
#pragma unroll
    for (int ni = 0; ni < 4; ++ni)
#pragma unroll
      for (int j = 0; j < 4; ++j) Cs[(wm * 64 + mi * 16 + quad * 4 + j) * CS_LD + wn * 64 + ni * 16 + lr] = acc[mi][ni][j];
}

DEV void ld8f(const float* src, float* v) {
  const float4 a = *reinterpret_cast<const float4*>(src), c = *reinterpret_cast<const float4*>(src + 4);
  v[0] = a.x; v[1] = a.y; v[2] = a.z; v[3] = a.w; v[4] = c.x; v[5] = c.y; v[6] = c.z; v[7] = c.w;
}

DEV void epi_rope64(const Params& p, float* Cs, u16* dst, int H, int h0, float scale, bool do_kpart, int b, int pos0, int tid) {
  const int pc = tid & 15, hh = pc >> 3, j0 = (pc & 7) * 4;
#pragma unroll
  for (int ps = 0; ps < 8; ++ps) {
    const int row = ps * 16 + (tid >> 4);
    const int pos = pos0 + row;
    float* cp = Cs + row * CS_LD + hh * 64 + j0;
    const float4 x1 = *reinterpret_cast<const float4*>(cp), x2 = *reinterpret_cast<const float4*>(cp + 32);
    const float4 c = *reinterpret_cast<const float4*>(P_cos64 + (size_t)pos * 32 + j0);
    const float4 sn = *reinterpret_cast<const float4*>(P_sin64 + (size_t)pos * 32 + j0);
    float4 o1, o2;
    o1.x = (x1.x * c.x - x2.x * sn.x) * scale; o2.x = (x2.x * c.x + x1.x * sn.x) * scale;
    o1.y = (x1.y * c.y - x2.y * sn.y) * scale; o2.y = (x2.y * c.y + x1.y * sn.y) * scale;
    o1.z = (x1.z * c.z - x2.z * sn.z) * scale; o2.z = (x2.z * c.z + x1.z * sn.z) * scale;
    o1.w = (x1.w * c.w - x2.w * sn.w) * scale; o2.w = (x2.w * c.w + x1.w * sn.w) * scale;
    u16* d = dst + ((size_t)((b * H + h0 + hh) * SEQ + pos)) * 64 + j0;
    st8b(d, o1.x, o1.y, o1.z, o1.w); st8b(d + 32, o2.x, o2.y, o2.z, o2.w);
    if (do_kpart) { *reinterpret_cast<float4*>(cp) = o1; *reinterpret_cast<float4*>(cp + 32) = o2; }
  }
  if (do_kpart) {
    __syncthreads();
    const int col = tid & 127, hf = tid >> 7;
    float sm = 0.f;
    for (int r = 0; r < 64; ++r) sm += Cs[(hf * 64 + r) * CS_LD + col];
    P_kpart[((size_t)((b * 8 + h0 + (col >> 6)) * 64 + (pos0 >> 6) + hf)) * 64 + (col & 63)] = sm;
  }
}

DEV void epi_plain_hm(const float* Cs, u16* dst, int H, int h0, float scale, int b, int pos0, int tid) {
  const int pc = tid & 15, hh = pc >> 3, j0 = (pc & 7) * 8;
#pragma unroll
  for (int ps = 0; ps < 8; ++ps) {
    const int row = ps * 16 + (tid >> 4);
    float v[8]; ld8f(Cs + row * CS_LD + pc * 8, v);
#pragma unroll
    for (int e = 0; e < 8; ++e) v[e] *= scale;
    st16b(dst + ((size_t)((b * H + h0 + hh) * SEQ + pos0 + row)) * 64 + j0, v);
  }
}

DEV void epi_vt(const float* Cs, u16* dst, int H, int h0, int DH, int b, int pos0, int tid) {
  for (int idx = tid; idx < 2048; idx += 256) {
    const int quad = idx & 3, c = (idx >> 2) & 127, g = idx >> 9;
    const int h = h0 + c / DH, d = c % DH;
    float v[8];
#pragma unroll
    for (int e = 0; e < 8; ++e) { int srow = g * 32 + (e >> 2) * 16 + quad * 4 + (e & 3); v[e] = Cs[srow * CS_LD + c]; }
    st16b(dst + (((size_t)((b * H + h) * 128 + (pos0 >> 5) + g)) * DH + d) * 32 + quad * 8, v);
  }
}

DEV void epi_silu(const float* Cs, u16* dst, int col0, int tok0, int tid) {
  const int pc = tid & 15;
#pragma unroll
  for (int ps = 0; ps < 8; ++ps) {
    const int row = ps * 16 + (tid >> 4);
    float v[8]; ld8f(Cs + row * CS_LD + pc * 8, v);
#pragma unroll
    for (int e = 0; e < 8; ++e) v[e] = silu_f(v[e]);
    st16b(dst + (size_t)(tok0 + row) * 1024 + col0 + pc * 8, v);
  }
}

DEV void rope32_piece(const Params& p, const float* Cs, int row, int pos, int ch, int j0, float scale, float4& o1, float4& o2) {
  const float* cp = Cs + row * CS_LD + ch * 32 + j0;
  const float4 x1 = *reinterpret_cast<const float4*>(cp), x2 = *reinterpret_cast<const float4*>(cp + 16);
  const float4 c = *reinterpret_cast<const float4*>(P_cos32 + (size_t)pos * 16 + j0);
  const float4 sn = *reinterpret_cast<const float4*>(P_sin32 + (size_t)pos * 16 + j0);
  o1.x = (x1.x * c.x - x2.x * sn.x) * scale; o2.x = (x2.x * c.x + x1.x * sn.x) * scale;
  o1.y = (x1.y * c.y - x2.y * sn.y) * scale; o2.y = (x2.y * c.y + x1.y * sn.y) * scale;
  o1.z = (x1.z * c.z - x2.z * sn.z) * scale; o2.z = (x2.z * c.z + x1.z * sn.z) * scale;
  o1.w = (x1.w * c.w - x2.w * sn.w) * scale; o2.w = (x2.w * c.w + x1.w * sn.w) * scale;
}

DEV void epilogue_inproj(const Params& p, int layer, int nt, float* Cs, int b, int pos0, int tid) {
  const int tok0 = b * SEQ + pos0;
  const int pc = tid & 15;
  if (layer == 0) {
    if (nt < 4) epi_rope64(p, Cs, P_AQ, 8, 2 * nt, 0.125f * LOG2E, false, b, pos0, tid);
    else if (nt < 8) epi_rope64(p, Cs, P_AK, 8, 2 * (nt - 4), 1.f, true, b, pos0, tid);
    else if (nt < 12) epi_vt(Cs, P_AVt, 8, 2 * (nt - 8), 64, b, pos0, tid);
    else if (nt < 16) epi_rope64(p, Cs, P_BQ, 8, 2 * (nt - 12), 0.125f * LOG2E, false, b, pos0, tid);
    else if (nt == 16) epi_rope64(p, Cs, P_BKk, 2, 0, 1.f, false, b, pos0, tid);
    else if (nt == 17) epi_vt(Cs, P_BVt, 2, 0, 64, b, pos0, tid);
    else epi_silu(Cs, P_SG, (nt - 18) * 128, tok0, tid);
  } else {
    const float qscale = 0.10206207261596575f * LOG2E;
    if (nt < 8) {
#pragma unroll
      for (int ps = 0; ps < 8; ++ps) {
        const int row = ps * 16 + (tid >> 4);
        float v[8]; ld8f(Cs + row * CS_LD + pc * 8, v);
#pragma unroll
        for (int e = 0; e < 8; ++e) v[e] *= qscale;
        st16b(P_QC + ((size_t)(tok0 + row) * 8 + nt) * 160 + pc * 8, v);
      }
    } else if (nt < 10 || nt == 12 || nt == 13) {
      const bool isq = nt < 10;
      const int ch = pc >> 2, j0 = (pc & 3) * 4;
      const int h = 4 * (isq ? (nt - 8) : (nt - 12)) + ch;
#pragma unroll
      for (int ps = 0; ps < 8; ++ps) {
        const int row = ps * 16 + (tid >> 4);
        float4 o1, o2; rope32_piece(p, Cs, row, pos0 + row, ch, j0, isq ? qscale : 1.f, o1, o2);
        u16* d = isq ? (P_QC + ((size_t)(tok0 + row) * 8 + h) * 160 + 128 + j0) : (P_IQ + ((size_t)(tok0 + row) * 8 + h) * 32 + j0);
        st8b(d, o1.x, o1.y, o1.z, o1.w); st8b(d + 16, o2.x, o2.y, o2.z, o2.w);
      }
    } else if (nt == 10) {
      float kg[8];
      ld8f(p.kvg + pc * 8, kg);
#pragma unroll
      for (int ps = 0; ps < 8; ++ps) {
        const int row = ps * 16 + (tid >> 4);
        float v[8]; ld8f(Cs + row * CS_LD + pc * 8, v);
        float ss = 0.f;
#pragma unroll
        for (int e = 0; e < 8; ++e) ss += v[e] * v[e];
        ss += __shfl_xor(ss, 1); ss += __shfl_xor(ss, 2); ss += __shfl_xor(ss, 4); ss += __shfl_xor(ss, 8);
        const float rinv = rsqrtf(ss * (1.f / 128.f) + LN_EPS);
#pragma unroll
        for (int e = 0; e < 8; ++e) { v[e] = v[e] * rinv * kg[e]; Cs[row * CS_LD + pc * 8 + e] = v[e]; }
        st16b(P_KVC + (size_t)(tok0 + row) * 160 + pc * 8, v);
      }
      __syncthreads();
      epi_vt(Cs, P_CKVt, 1, 0, 128, b, pos0, tid);
    } else if (nt == 11) {
      const int ch = pc >> 2, j0 = (pc & 3) * 4;
#pragma unroll
      for (int ps = 0; ps < 8; ++ps) {
        const int row = ps * 16 + (tid >> 4);
        if (ch < 2) {
          float4 o1, o2; rope32_piece(p, Cs, row, pos0 + row, ch, j0, 1.f, o1, o2);
          u16* d = (ch == 0) ? (P_KVC + (size_t)(tok0 + row) * 160 + 128 + j0) : (P_IK + (size_t)(tok0 + row) * 32 + j0);
          st8b(d, o1.x, o1.y, o1.z, o1.w); st8b(d + 16, o2.x, o2.y, o2.z, o2.w);
        } else if (pc == 8 || pc == 9) {
          const float4 w = *reinterpret_cast<const float4*>(Cs + row * CS_LD + 64 + (pc - 8) * 4);
          *reinterpret_cast<float4*>(P_IW + (size_t)(tok0 + row) * 8 + (pc - 8) * 4) = w;
        }
      }
    } else if (nt < 18) epi_plain_hm(Cs, P_DQ, 8, 2 * (nt - 14), 0.125f, b, pos0, tid);
    else if (nt < 22) epi_plain_hm(Cs, P_DK, 8, 2 * (nt - 18), 1.f, b, pos0, tid);
    else if (nt < 26) epi_vt(Cs, P_DVt, 8, 2 * (nt - 22), 64, b, pos0, tid);
    else epi_silu(Cs, P_SG, (nt - 26) * 128, tok0, tid);
  }
}

DEV void phase_inproj(const Params& p, int layer, char* smem, int tid_in, int vid) {
  const int NT = layer == 0 ? 26 : 34;
  const int total = 128 * NT;
  float* Cs = reinterpret_cast<float*>(smem);
  const int G = gridDim.x;
  const int nfull = total / G, ntail = total - nfull * G;
  const int tstride = (ntail > 0 && (G % ntail) == 0) ? (G / ntail) : 1;
  const bool has_tail = (ntail > 0) && ((tstride > 1) ? ((vid % tstride) == 0) : (vid < ntail));
  const int nmine = nfull + (has_tail ? 1 : 0);
  for (int rr = 0; rr < nmine; ++rr) {
    const int it = (rr < nfull) ? (rr * G + vid) : (nfull * G + ((tstride > 1) ? (vid / tstride) : vid));
    const int tid = opq(tid_in);
    const int panel = it / (8 * NT), rem = it % (8 * NT);
    const int nt = rem >> 3, mt = panel * 8 + (rem & 7);
    const int m0 = mt * 128, n0 = nt * 128;
    const int b = m0 >> 12;
    f32x4 acc[4][4];
    gemm_mainloop<false>(P_H, layer == 0 ? P_WTe : P_WTo, m0, n0, nullptr, nullptr, nullptr, nullptr, nullptr, smem, acc, tid);
    stage_all(acc, Cs, tid);
    __syncthreads();
    epilogue_inproj(p, layer, nt, Cs, b, (m0 & 4095), tid);
    __syncthreads();
  }
}

DEV float half32_sum_at31(float v) {
  float x = v;
  x += __builtin_amdgcn_update_dpp(0.f, x, 0x111, 0xf, 0xf, false);
  x += __builtin_amdgcn_update_dpp(0.f, x, 0x112, 0xf, 0xf, false);
  x += __builtin_amdgcn_update_dpp(0.f, x, 0x114, 0xf, 0xf, false);
  x += __builtin_amdgcn_update_dpp(0.f, x, 0x118, 0xf, 0xf, false);
  const auto r = __builtin_amdgcn_permlane16_swap(__float_as_uint(x), __float_as_uint(x), false, false);
  return __uint_as_float(r[0]) + __uint_as_float(r[1]);
}
DEV void phase_outproj(const Params& p, int layer, char* smem, int tid_in, int vid) {
  float* Cs = reinterpret_cast<float*>(smem);
  float* rowstat = reinterpret_cast<float*>(smem + ROWSTAT_OFF);
  const u16* Bt = P_WOT + (size_t)layer * 1024 * 1024;
  float* stats_out = layer == 0 ? P_stats0 : P_stats1;
  for (int it = vid; it < 128 * 8; it += gridDim.x) {
    const int tid = opq(tid_in);
    const int nt = (it >> 3) & 7, mt = (it >> 6) * 8 + (it & 7);
    const int m0 = mt * 128, n0 = nt * 128;
    const int b = m0 >> 12;
    f32x4 acc[4][4];
    gemm_mainloop<false>(P_OG, Bt, m0, n0, nullptr, nullptr, nullptr, nullptr, nullptr, smem, acc, tid);
    if (layer == 1) {
      if (tid < 128) { float mu, rs; row_stats_from_partials(P_stats0, m0 + tid, mu, rs); rowstat[tid * 2] = mu; rowstat[tid * 2 + 1] = rs; }
    }
    const float* gate = P_mods + (size_t)(layer * 4 + b) * 3072 + 2048;
    stage_all(acc, Cs, tid);
    __syncthreads();
    {
      const int l32 = tid & 31, rgrp = tid >> 5;
      const int gc = n0 + l32 * 4;
      const float4 gt = *reinterpret_cast<const float4*>(gate + gc);
      float4 lg = make_float4(0.f, 0.f, 0.f, 0.f), lb = lg;
      if (layer == 1) { lg = *reinterpret_cast<const float4*>(p.ln_g + gc); lb = *reinterpret_cast<const float4*>(p.ln_b + gc); }
#pragma unroll 4
      for (int ps = 0; ps < 16; ++ps) {
        const int lrow = ps * 8 + rgrp;
        const size_t grow = (size_t)(m0 + lrow);
        float4 xr;
        if (layer == 0) xr = *reinterpret_cast<const float4*>(p.x + grow * 1024 + gc);
        else {
          const float mu = rowstat[lrow * 2], rs = rowstat[lrow * 2 + 1];
          const float4 v0 = ld4bf(reinterpret_cast<const u16*>(p.out) + grow * 1024 + gc);
          xr.x = (v0.x - mu) * rs * lg.x + lb.x; xr.y = (v0.y - mu) * rs * lg.y + lb.y;
          xr.z = (v0.z - mu) * rs * lg.z + lb.z; xr.w = (v0.w - mu) * rs * lg.w + lb.w;
        }
        const float4 y = *reinterpret_cast<const float4*>(Cs + lrow * CS_LD + l32 * 4);
        float4 v;
        v.x = DN_ALPHA * xr.x + (1.f + gt.x) * y.x; v.y = DN_ALPHA * xr.y + (1.f + gt.y) * y.y;
        v.z = DN_ALPHA * xr.z + (1.f + gt.z) * y.z; v.w = DN_ALPHA * xr.w + (1.f + gt.w) * y.w;
        float sm = v.x + v.y + v.z + v.w, ss = v.x * v.x + v.y * v.y + v.z * v.z + v.w * v.w;
        if (layer == 1) st8b(P_V1B + grow * 1024 + gc, v.x, v.y, v.z, v.w);
        else st8b(reinterpret_cast<u16*>(p.out) + grow * 1024 + gc, v.x, v.y, v.z, v.w);
        sm = half32_sum_at31(sm); ss = half32_sum_at31(ss);
        if (l32 == 31) { stats_out[grow * 16 + nt * 2] = sm; stats_out[grow * 16 + nt * 2 + 1] = ss; }
      }
    }
    __syncthreads();
  }
}

DEV void phase_prep(const Params& p, int layer, int tid) {
  const int lane = tid & 63;
  const int gw = blockIdx.x * 4 + (tid >> 6), nw = gridDim.x * 4;
  for (int row = gw; row < NTOK; row += nw) {
    const int b = row >> 12;
    const float* modb = P_mods + (size_t)(layer * 4 + b) * 3072;
    const float* src = p.x + (size_t)row * 1024;
    const u16* srcb = reinterpret_cast<const u16*>(p.out) + (size_t)row * 1024;
    float mu = 0.f, rs = 1.f;
    if (layer == 1) row_stats_from_partials(P_stats0, row, mu, rs);
    u16* dst = P_H + (size_t)row * 1024;
#pragma unroll
    for (int i = 0; i < 4; ++i) {
      const int c = i * 256 + lane * 4;
      float4 v;
      if (layer == 0) v = *reinterpret_cast<const float4*>(src + c); else v = ld4bf(srcb + c);
      if (layer == 1) {
        const float4 g = *reinterpret_cast<const float4*>(p.ln_g + c);
        const float4 bb = *reinterpret_cast<const float4*>(p.ln_b + c);
        v.x = (v.x - mu) * rs * g.x + bb.x; v.y = (v.y - mu) * rs * g.y + bb.y;
        v.z = (v.z - mu) * rs * g.z + bb.z; v.w = (v.w - mu) * rs * g.w + bb.w;
      }
      const float4 sh = *reinterpret_cast<const float4*>(modb + c);
      const float4 sc = *reinterpret_cast<const float4*>(modb + 1024 + c);
      st8b(dst + c, v.x * (1.f + sc.x) + sh.x, v.y * (1.f + sc.y) + sh.y, v.z * (1.f + sc.z) + sh.z, v.w * (1.f + sc.w) + sh.w);
    }
  }
}

DEV void phase_final_ln(const Params& p, int tid) {
  const int lane = tid & 63;
  const int gw = blockIdx.x * 4 + (tid >> 6), nw = gridDim.x * 4;
  const float* g = p.ln_g + 1024; const float* bb = p.ln_b + 1024;
  for (int row = gw; row < NTOK; row += nw) {
    float mu, rs; row_stats_from_partials(P_stats1, row, mu, rs);
    float* rp = p.out + (size_t)row * 1024;
    const u16* vp = P_V1B + (size_t)row * 1024;
#pragma unroll
    for (int i = 0; i < 4; ++i) {
      const int c = i * 256 + lane * 4;
      const uint2 vb = *reinterpret_cast<const uint2*>(vp + c);
      float4 v;
      v.x = bf2f((u16)(vb.x & 0xFFFF)); v.y = bf2f((u16)(vb.x >> 16)); v.z = bf2f((u16)(vb.y & 0xFFFF)); v.w = bf2f((u16)(vb.y >> 16));
      float4 gg = *reinterpret_cast<const float4*>(g + c);
      float4 b4 = *reinterpret_cast<const float4*>(bb + c);
      v.x = (v.x - mu) * rs * gg.x + b4.x; v.y = (v.y - mu) * rs * gg.y + b4.y;
      v.z = (v.z - mu) * rs * gg.z + b4.z; v.w = (v.w - mu) * rs * gg.w + b4.w;
      *reinterpret_cast<float4*>(rp + c) = v;
    }
  }
}

DEV float xq_max(float x) {
  unsigned u = __float_as_uint(x);
  auto r = __builtin_amdgcn_permlane32_swap(u, u, false, false);
  const float m = fmaxf(__uint_as_float(r[0]), __uint_as_float(r[1]));
  unsigned v = __float_as_uint(m);
  auto s2 = __builtin_amdgcn_permlane16_swap(v, v, false, false);
  return fmaxf(__uint_as_float(s2[0]), __uint_as_float(s2[1]));
}
DEV float xq_sum(float x) {
  unsigned u = __float_as_uint(x);
  auto r = __builtin_amdgcn_permlane32_swap(u, u, false, false);
  const float m = __uint_as_float(r[0]) + __uint_as_float(r[1]);
  unsigned v = __float_as_uint(m);
  auto s2 = __builtin_amdgcn_permlane16_swap(v, v, false, false);
  return __uint_as_float(s2[0]) + __uint_as_float(s2[1]);
}
template <int NKS, int NDT, class MaskF>
DEV void flash_chunk(const u16* __restrict__ Kc, int ldk, const u16* __restrict__ Vc, const bf16x8 (&qf)[2][NKS],
                     float (&m)[2], float (&l)[2], f32x4 (&o)[NDT][2], int lane, MaskF mask) {
  const int lr = lane & 15, quad = lane >> 4;
  f32x4 st[4][2];
#pragma unroll
  for (int kt = 0; kt < 4; ++kt) { st[kt][0] = f32x4{0.f, 0.f, 0.f, 0.f}; st[kt][1] = f32x4{0.f, 0.f, 0.f, 0.f}; }
#pragma unroll
  for (int kt = 0; kt < 4; ++kt)
#pragma unroll
    for (int ks = 0; ks < NKS; ++ks) {
      bf16x8 kf = ld8(Kc + (size_t)(kt * 16 + lr) * ldk + ks * 32 + quad * 8);
      st[kt][0] = mfma16(kf, qf[0][ks], st[kt][0]);
      st[kt][1] = mfma16(kf, qf[1][ks], st[kt][1]);
    }
#pragma unroll
  for (int c = 0; c < 2; ++c) {
    float cm = NEG_INF;
#pragma unroll
    for (int kt = 0; kt < 4; ++kt)
#pragma unroll
      for (int j = 0; j < 4; ++j) { float s = mask(kt, j, c) ? st[kt][c][j] : NEG_INF; st[kt][c][j] = s; cm = fmaxf(cm, s); }
    cm = xq_max(cm);
    const float mn = fmaxf(m[c], cm);
    const float ms = (mn == NEG_INF) ? 0.f : mn;
    const float alpha = fexp2(m[c] - ms);
    m[c] = mn;
    float ps = 0.f;
#pragma unroll
    for (int kt = 0; kt < 4; ++kt)
#pragma unroll
      for (int j = 0; j < 4; ++j) { float pv = fexp2(st[kt][c][j] - ms); st[kt][c][j] = pv; ps += pv; }
    l[c] = l[c] * alpha + ps;
#pragma unroll
    for (int dt = 0; dt < NDT; ++dt) { o[dt][c][0] *= alpha; o[dt][c][1] *= alpha; o[dt][c][2] *= alpha; o[dt][c][3] *= alpha; }
  }
  bf16x8 pb[2][2];
#pragma unroll
  for (int c = 0; c < 2; ++c)
#pragma unroll
    for (int g = 0; g < 2; ++g)
      pb[c][g] = pack8(st[2 * g][c][0], st[2 * g][c][1], st[2 * g][c][2], st[2 * g][c][3],
                       st[2 * g + 1][c][0], st[2 * g + 1][c][1], st[2 * g + 1][c][2], st[2 * g + 1][c][3]);
#pragma unroll
  for (int g = 0; g < 2; ++g)
#pragma unroll
    for (int dt = 0; dt < NDT; ++dt) {
      bf16x8 vf = ld8(Vc + ((size_t)((g * NDT + dt) * 16 + lr) * 4 + quad) * 8);
      o[dt][0] = mfma16(vf, pb[0][g], o[dt][0]);
      o[dt][1] = mfma16(vf, pb[1][g], o[dt][1]);
    }
}

DEV void load_kv64(const u16* __restrict__ Kc, const u16* __restrict__ Vc, bf16x8 (&kf)[4][2], bf16x8 (&vf)[2][4], int lane) {
  const int lr = lane & 15, quad = lane >> 4;
#pragma unroll
  for (int kt = 0; kt < 4; ++kt)
#pragma unroll
    for (int ks = 0; ks < 2; ++ks) kf[kt][ks] = ld8(Kc + (size_t)(kt * 16 + lr) * 64 + ks * 32 + quad * 8);
#pragma unroll
  for (int g = 0; g < 2; ++g)
#pragma unroll
    for (int dt = 0; dt < 4; ++dt) vf[g][dt] = ld8(Vc + ((size_t)((g * 4 + dt) * 16 + lr) * 4 + quad) * 8);
}
DEV void copy_kv64(bf16x8 (&kd)[4][2], bf16x8 (&vd)[2][4], const bf16x8 (&ks_)[4][2], const bf16x8 (&vs)[2][4]) {
#pragma unroll
  for (int a = 0; a < 4; ++a) { kd[a][0] = ks_[a][0]; kd[a][1] = ks_[a][1]; }
#pragma unroll
  for (int g = 0; g < 2; ++g)
#pragma unroll
    for (int dt = 0; dt < 4; ++dt) vd[g][dt] = vs[g][dt];
}
template <class MaskF>
DEV void flash_chunk_pre(const bf16x8 (&kf)[4][2], const bf16x8 (&vf)[2][4], const bf16x8 (&qf)[2][2],
                         float (&m)[2], float (&l)[2], f32x4 (&o)[4][2], int lane, MaskF mask) {
  f32x4 st[4][2];
#pragma unroll
  for (int kt = 0; kt < 4; ++kt) {
    st[kt][0] = f32x4{0.f, 0.f, 0.f, 0.f}; st[kt][1] = f32x4{0.f, 0.f, 0.f, 0.f};
#pragma unroll
    for (int ks = 0; ks < 2; ++ks) { st[kt][0] = mfma16(kf[kt][ks], qf[0][ks], st[kt][0]); st[kt][1] = mfma16(kf[kt][ks], qf[1][ks], st[kt][1]); }
  }
#pragma unroll
  for (int c = 0; c < 2; ++c) {
    float cm = NEG_INF;
#pragma unroll
    for (int kt = 0; kt < 4; ++kt)
#pragma unroll
      for (int j = 0; j < 4; ++j) { float sv = mask(kt, j, c) ? st[kt][c][j] : NEG_INF; st[kt][c][j] = sv; cm = fmaxf(cm, sv); }
    cm = xq_max(cm);
    if (!__all(cm <= m[c] + 8.f)) {
      const float mn = fmaxf(m[c], cm);
      const float msn = (mn == NEG_INF) ? 0.f : mn;
      const float alpha = fexp2(m[c] - msn);
      m[c] = mn;
      l[c] *= alpha;
#pragma unroll
      for (int dt = 0; dt < 4; ++dt) { o[dt][c][0] *= alpha; o[dt][c][1] *= alpha; o[dt][c][2] *= alpha; o[dt][c][3] *= alpha; }
    }
    const float ms = (m[c] == NEG_INF) ? 0.f : m[c];
    float ps = 0.f;
#pragma unroll
    for (int kt = 0; kt < 4; ++kt)
#pragma unroll
      for (int j = 0; j < 4; ++j) { float pv = fexp2(st[kt][c][j] - ms); st[kt][c][j] = pv; ps += pv; }
    l[c] += ps;
  }
#pragma unroll
  for (int g = 0; g < 2; ++g) {
    const bf16x8 p0 = pack8(st[2 * g][0][0], st[2 * g][0][1], st[2 * g][0][2], st[2 * g][0][3], st[2 * g + 1][0][0], st[2 * g + 1][0][1], st[2 * g + 1][0][2], st[2 * g + 1][0][3]);
    const bf16x8 p1 = pack8(st[2 * g][1][0], st[2 * g][1][1], st[2 * g][1][2], st[2 * g][1][3], st[2 * g + 1][1][0], st[2 * g + 1][1][1], st[2 * g + 1][1][2], st[2 * g + 1][1][3]);
#pragma unroll
    for (int dt = 0; dt < 4; ++dt) { o[dt][0] = mfma16(vf[g][dt], p0, o[dt][0]); o[dt][1] = mfma16(vf[g][dt], p1, o[dt][1]); }
  }
}

DEV void write_og4(const Params& p, f32x4 (&o)[4][2], const float (&inv)[2], int b, int tq0, int colbase, int lane) {
  const int lr = lane & 15, quad = lane >> 4;
#pragma unroll
  for (int c = 0; c < 2; ++c) {
    const size_t base = ((size_t)(b * SEQ + tq0 + c * 16 + lr)) * 1024 + colbase + quad * 4;
#pragma unroll
    for (int dt = 0; dt < 4; ++dt) {
      uint2 sg = *reinterpret_cast<const uint2*>(P_SG + base + dt * 16);
      float g0 = bf2f((u16)(sg.x & 0xFFFF)), g1 = bf2f((u16)(sg.x >> 16)), g2 = bf2f((u16)(sg.y & 0xFFFF)), g3 = bf2f((u16)(sg.y >> 16));
      st8b(P_OG + base + dt * 16, o[dt][c][0] * inv[c] * g0, o[dt][c][1] * inv[c] * g1, o[dt][c][2] * inv[c] * g2, o[dt][c][3] * inv[c] * g3);
    }
  }
}

DEV float quad_sum(float v) { return xq_sum(v); }

DEV void moba_item(const Params& p, int b, int h, int qt, int wave, int lane, char* smem) {
  const int lr = lane & 15, quad = lane >> 4;
  const int q0 = qt * 128 + wave * 32;
  const int own = q0 >> 8;
  const size_t hb = (size_t)(b * 8 + h) * SEQ * 64;
  const u16* Q = P_AQ + hb; const u16* K = P_AK + hb; const u16* Vt = P_AVt + hb;
  bf16x8 qf[2][2];
#pragma unroll
  for (int c = 0; c < 2; ++c)
#pragma unroll
    for (int ks = 0; ks < 2; ++ks) qf[c][ks] = ld8(Q + (size_t)(q0 + c * 16 + lr) * 64 + ks * 32 + quad * 8);
  unsigned selmask[2] = {0u, 0u};
  if (own > 0) {
    bf16x8 kmf[2];
#pragma unroll
    for (int ks = 0; ks < 2; ++ks) {
      float s[8];
#pragma unroll
      for (int e = 0; e < 8; ++e) s[e] = 0.f;
      if (lr < own) {
#pragma unroll
        for (int part = 0; part < 4; ++part) {
          const float* kp = P_kpart + ((size_t)((b * 8 + h) * 64 + lr * 4 + part)) * 64 + ks * 32 + quad * 8;
          float4 a = *reinterpret_cast<const float4*>(kp); float4 bq = *reinterpret_cast<const float4*>(kp + 4);
          s[0] += a.x; s[1] += a.y; s[2] += a.z; s[3] += a.w; s[4] += bq.x; s[5] += bq.y; s[6] += bq.z; s[7] += bq.w;
        }
      }
      const float r = 1.f / 256.f;
      kmf[ks] = pack8(s[0] * r, s[1] * r, s[2] * r, s[3] * r, s[4] * r, s[5] * r, s[6] * r, s[7] * r);
    }
#pragma unroll
    for (int c = 0; c < 2; ++c) {
      f32x4 g = f32x4{0.f, 0.f, 0.f, 0.f};
      g = mfma16(kmf[0], qf[c][0], g); g = mfma16(kmf[1], qf[c][1], g);
      float v[4];
#pragma unroll
      for (int j = 0; j < 4; ++j) v[j] = (quad * 4 + j < own) ? g[j] : NEG_INF;
      unsigned sm = 0u;
#pragma unroll
      for (int itr = 0; itr < 3; ++itr) {
        float best = NEG_INF; int bi = 99;
#pragma unroll
        for (int j = 0; j < 4; ++j) if (v[j] > best) { best = v[j]; bi = quad * 4 + j; }
#pragma unroll
        for (int off = 16; off <= 32; off <<= 1) {
          float ob = __shfl_xor(best, off); int oi = __shfl_xor(bi, off);
          if (ob > best || (ob == best && oi < bi)) { best = ob; bi = oi; }
        }
        if (bi < 16) {
          sm |= 1u << bi;
#pragma unroll
          for (int j = 0; j < 4; ++j) if (quad * 4 + j == bi) v[j] = NEG_INF;
        }
      }
      selmask[c] = sm;
    }
  }
  float m[2] = {NEG_INF, NEG_INF}, l[2] = {0.f, 0.f};
  f32x4 o[4][2];
#pragma unroll
  for (int dt = 0; dt < 4; ++dt) { o[dt][0] = f32x4{0.f, 0.f, 0.f, 0.f}; o[dt][1] = f32x4{0.f, 0.f, 0.f, 0.f}; }
  {
    const int tid = wave * 64 + lane;
    const int cend_w = (q0 + 31) >> 6;
    const int cend_b = (qt * 128 + 127) >> 6;
    uint4 r0, r1, r2, r3;
    const int kid0 = tid, kid1 = tid + 256;
    const int krow0 = kid0 >> 3, kc0 = kid0 & 7, krow1 = kid1 >> 3, kc1 = kid1 & 7;
    const int kst0 = krow0 * 128 + ((kc0 ^ ((krow0 >> 1) & 7)) << 4), kst1 = krow1 * 128 + ((kc1 ^ ((krow1 >> 1) & 7)) << 4);
    const int vlr0 = (kid0 >> 2) & 15, vq0 = kid0 & 3, vlr1 = (kid1 >> 2) & 15, vq1 = kid1 & 3;
    const int vst0 = 8192 + (kid0 >> 6) * 1024 + vlr0 * 64 + ((vq0 ^ (vlr0 >= 8 ? 3 : 0)) << 4);
    const int vst1 = 8192 + (kid1 >> 6) * 1024 + vlr1 * 64 + ((vq1 ^ (vlr1 >= 8 ? 3 : 0)) << 4);
#define MOBA_LOAD(CH) do { const u16* kg_ = K + (size_t)(CH) * 64 * 64; const u16* vg_ = Vt + (size_t)(CH) * 2 * 64 * 32; \
      r0 = *reinterpret_cast<const uint4*>(kg_ + kid0 * 8); r1 = *reinterpret_cast<const uint4*>(kg_ + kid1 * 8); \
      r2 = *reinterpret_cast<const uint4*>(vg_ + kid0 * 8); r3 = *reinterpret_cast<const uint4*>(vg_ + kid1 * 8); } while (0)
#define MOBA_STORE(STG) do { char* sb_ = smem + (STG) * 16384; \
      *reinterpret_cast<uint4*>(sb_ + kst0) = r0; *reinterpret_cast<uint4*>(sb_ + kst1) = r1; \
      *reinterpret_cast<uint4*>(sb_ + vst0) = r2; *reinterpret_cast<uint4*>(sb_ + vst1) = r3; } while (0)
    const int kro = lr * 128, ksw = (lr >> 1) & 7;
    const int vro = 8192 + lr * 64 + ((quad ^ (lr >= 8 ? 3 : 0)) << 4);
    MOBA_LOAD(0);
    MOBA_STORE(0);
    if (cend_b >= 1) MOBA_LOAD(1);
    __syncthreads();
    for (int chk = 0; chk <= cend_b; ++chk) {
      if (chk + 1 <= cend_b) MOBA_STORE((chk + 1) & 1);
      if (chk + 2 <= cend_b) MOBA_LOAD(chk + 2);
      const int cb = chk * 64, n = chk >> 2;
      const bool past = n < own;
      const bool s0 = (selmask[0] >> n) & 1u, s1 = (selmask[1] >> n) & 1u;
      if (chk <= cend_w && (!past || __ballot(s0 || s1) != 0ull)) {
        const char* sb = smem + (chk & 1) * 16384;
        bf16x8 kc[4][2], vc[2][4];
#pragma unroll
        for (int kt = 0; kt < 4; ++kt)
#pragma unroll
          for (int ks = 0; ks < 2; ++ks) kc[kt][ks] = *reinterpret_cast<const bf16x8*>(sb + kt * 2048 + kro + (((ks * 4 + quad) ^ ksw) << 4));
#pragma unroll
        for (int g = 0; g < 2; ++g)
#pragma unroll
          for (int dt = 0; dt < 4; ++dt) vc[g][dt] = *reinterpret_cast<const bf16x8*>(sb + (g * 4 + dt) * 1024 + vro);
        flash_chunk_pre(kc, vc, qf, m, l, o, lane,
                        [&](int kt, int j, int c) { return past ? (c ? s1 : s0) : ((cb + kt * 16 + quad * 4 + j) <= (q0 + c * 16 + lr)); });
      }
      __syncthreads();
    }
  }
  float inv[2];
  inv[0] = 1.f / quad_sum(l[0]); inv[1] = 1.f / quad_sum(l[1]);
  write_og4(p, o, inv, b, q0, h * 64, lane);
}

DEV void swa_item(const Params& p, int b, int kvh, int t32, int wave, int lane, char* smem) {
  const int lr = lane & 15, quad = lane >> 4;
  const int q0 = t32 * 32;
  const int qh = kvh * 4 + wave;
  const u16* Q = P_BQ + (size_t)(b * 8 + qh) * SEQ * 64;
  const u16* K = P_BKk + (size_t)(b * 2 + kvh) * SEQ * 64;
  const u16* Vt = P_BVt + (size_t)(b * 2 + kvh) * SEQ * 64;
  bf16x8 qf[2][2];
#pragma unroll
  for (int c = 0; c < 2; ++c)
#pragma unroll
    for (int ks = 0; ks < 2; ++ks) qf[c][ks] = ld8(Q + (size_t)(q0 + c * 16 + lr) * 64 + ks * 32 + quad * 8);
  float m[2] = {NEG_INF, NEG_INF}, l[2] = {0.f, 0.f};
  f32x4 o[4][2];
#pragma unroll
  for (int dt = 0; dt < 4; ++dt) { o[dt][0] = f32x4{0.f, 0.f, 0.f, 0.f}; o[dt][1] = f32x4{0.f, 0.f, 0.f, 0.f}; }
  {
    const int tid = wave * 64 + lane;
    const int lo = (q0 - 127) > 0 ? (q0 - 127) : 0;
    const int c0 = lo >> 6, c1 = (q0 + 31) >> 6;
    uint4 r0, r1, r2, r3;
    const int kid0 = tid, kid1 = tid + 256;
    const int krow0 = kid0 >> 3, kc0 = kid0 & 7, krow1 = kid1 >> 3, kc1 = kid1 & 7;
    const int kst0 = krow0 * 128 + ((kc0 ^ ((krow0 >> 1) & 7)) << 4), kst1 = krow1 * 128 + ((kc1 ^ ((krow1 >> 1) & 7)) << 4);
    const int vlr0 = (kid0 >> 2) & 15, vq0 = kid0 & 3, vlr1 = (kid1 >> 2) & 15, vq1 = kid1 & 3;
    const int vst0 = 8192 + (kid0 >> 6) * 1024 + vlr0 * 64 + ((vq0 ^ (vlr0 >= 8 ? 3 : 0)) << 4);
    const int vst1 = 8192 + (kid1 >> 6) * 1024 + vlr1 * 64 + ((vq1 ^ (vlr1 >= 8 ? 3 : 0)) << 4);
    const int kro = lr * 128, ksw = (lr >> 1) & 7;
    const int vro = 8192 + lr * 64 + ((quad ^ (lr >= 8 ? 3 : 0)) << 4);
    MOBA_LOAD(c0);
    MOBA_STORE(0);
    if (c0 + 1 <= c1) MOBA_LOAD(c0 + 1);
    __syncthreads();
    for (int chk = c0; chk <= c1; ++chk) {
      const int stg = (chk - c0) & 1;
      if (chk + 1 <= c1) MOBA_STORE(stg ^ 1);
      if (chk + 2 <= c1) MOBA_LOAD(chk + 2);
      const int cb = chk * 64;
      {
        const char* sb = smem + stg * 16384;
        bf16x8 kc[4][2], vc[2][4];
#pragma unroll
        for (int kt = 0; kt < 4; ++kt)
#pragma unroll
          for (int ks = 0; ks < 2; ++ks) kc[kt][ks] = *reinterpret_cast<const bf16x8*>(sb + kt * 2048 + kro + (((ks * 4 + quad) ^ ksw) << 4));
#pragma unroll
        for (int g = 0; g < 2; ++g)
#pragma unroll
          for (int dt = 0; dt < 4; ++dt) vc[g][dt] = *reinterpret_cast<const bf16x8*>(sb + (g * 4 + dt) * 1024 + vro);
        flash_chunk_pre(kc, vc, qf, m, l, o, lane,
                        [&](int kt, int j, int c) { int key = cb + kt * 16 + quad * 4 + j; int t = q0 + c * 16 + lr; return key <= t && key > t - 128; });
      }
      __syncthreads();
    }
  }
  const float sl = p.sinks[qh] * LOG2E;
  float inv[2];
#pragma unroll
  for (int c = 0; c < 2; ++c) {
    float lt = quad_sum(l[c]);
    float mf = fmaxf(m[c], sl);
    float a = fexp2(m[c] - mf);
    inv[c] = a / (lt * a + fexp2(sl - mf));
  }
  write_og4(p, o, inv, b, q0, 512 + qh * 64, lane);
}

DEV void sb_item(const Params& p, int b, int h, int qt, int wave, int lane) {
  const int lr = lane & 15, quad = lane >> 4;
  const int q0 = qt * 128 + wave * 32;
  const size_t hb = (size_t)(b * 8 + h) * SEQ * 64;
  const u16* Q = P_DQ + hb; const u16* K = P_DK + hb; const u16* Vt = P_DVt + hb;
  bf16x8 qf[2][2];
#pragma unroll
  for (int c = 0; c < 2; ++c)
#pragma unroll
    for (int ks = 0; ks < 2; ++ks) qf[c][ks] = ld8(Q + (size_t)(q0 + c * 16 + lr) * 64 + ks * 32 + quad * 8);
  float carry[2] = {0.f, 0.f};
  f32x4 o[4][2];
#pragma unroll
  for (int dt = 0; dt < 4; ++dt) { o[dt][0] = f32x4{0.f, 0.f, 0.f, 0.f}; o[dt][1] = f32x4{0.f, 0.f, 0.f, 0.f}; }
  bf16x8 kc[4][2], kn[4][2], vc[2][4];
  {
    const u16* Kc0 = K + (size_t)((q0 + 31) >> 6) * 64 * 64;
#pragma unroll
    for (int kt = 0; kt < 4; ++kt)
#pragma unroll
      for (int ks = 0; ks < 2; ++ks) kc[kt][ks] = ld8(Kc0 + (size_t)(kt * 16 + lr) * 64 + ks * 32 + quad * 8);
  }
  for (int chk = (q0 + 31) >> 6; chk >= 0; --chk) {
    const int cb = chk * 64;
    {
      const u16* Vc = Vt + (size_t)chk * 2 * 64 * 32;
#pragma unroll
      for (int g = 0; g < 2; ++g)
#pragma unroll
        for (int dt = 0; dt < 4; ++dt) vc[g][dt] = ld8(Vc + ((size_t)((g * 4 + dt) * 16 + lr) * 4 + quad) * 8);
    }
    if (chk > 0) {
      const u16* Kn = K + (size_t)(chk - 1) * 64 * 64;
#pragma unroll
      for (int kt = 0; kt < 4; ++kt)
#pragma unroll
        for (int ks = 0; ks < 2; ++ks) kn[kt][ks] = ld8(Kn + (size_t)(kt * 16 + lr) * 64 + ks * 32 + quad * 8);
    }
    f32x4 st[4][2];
#pragma unroll
    for (int kt = 0; kt < 4; ++kt) {
      st[kt][0] = f32x4{0.f, 0.f, 0.f, 0.f}; st[kt][1] = f32x4{0.f, 0.f, 0.f, 0.f};
#pragma unroll
      for (int ks = 0; ks < 2; ++ks) { st[kt][0] = mfma16(kc[kt][ks], qf[0][ks], st[kt][0]); st[kt][1] = mfma16(kc[kt][ks], qf[1][ks], st[kt][1]); }
    }
#pragma unroll
    for (int c = 0; c < 2; ++c) {
      const int t = q0 + c * 16 + lr;
      float lk[4][4], hq[4], tot[4];
#pragma unroll
      for (int kt = 0; kt < 4; ++kt) {
        float g = 0.f;
#pragma unroll
        for (int j = 0; j < 4; ++j) {
          const int key = cb + kt * 16 + quad * 4 + j;
          const float z = st[kt][c][j];
          const float sp = fmaxf(z, 0.f) + flog(1.f + fexp(-fabsf(z)));
          const float v = (key < t) ? -sp : 0.f;
          lk[kt][j] = v; g += v;
        }
        const auto r16 = __builtin_amdgcn_permlane16_swap(__float_as_uint(g), __float_as_uint(g), false, false);
        const float od = __uint_as_float(r16[1]);
        const float psum = __uint_as_float(r16[0]) + od;
        const auto r32 = __builtin_amdgcn_permlane32_swap(__float_as_uint(psum), __float_as_uint(psum), false, false);
        const float p01 = __uint_as_float(r32[0]), p23 = __uint_as_float(r32[1]);
        hq[kt] = (quad == 0) ? (od + p23) : (quad == 1) ? p23 : (quad == 2) ? od : 0.f;
        tot[kt] = p01 + p23;
      }
      float run = carry[c];
#pragma unroll
      for (int kt = 3; kt >= 0; --kt) {
        const float base = run + hq[kt];
        float ex = 0.f;
#pragma unroll
        for (int j = 3; j >= 0; --j) {
          const int key = cb + kt * 16 + quad * 4 + j;
          const float z = st[kt][c][j];
          const float a = (key < t) ? fexp(z + lk[kt][j] + base + ex) : 0.f;
          st[kt][c][j] = a;
          ex += lk[kt][j];
        }
        run += tot[kt];
      }
      carry[c] = run;
    }
    bf16x8 pb[2][2];
#pragma unroll
    for (int c = 0; c < 2; ++c)
#pragma unroll
      for (int g = 0; g < 2; ++g)
        pb[c][g] = pack8(st[2 * g][c][0], st[2 * g][c][1], st[2 * g][c][2], st[2 * g][c][3],
                         st[2 * g + 1][c][0], st[2 * g + 1][c][1], st[2 * g + 1][c][2], st[2 * g + 1][c][3]);
#pragma unroll
    for (int g = 0; g < 2; ++g)
#pragma unroll
      for (int dt = 0; dt < 4; ++dt) {
        o[dt][0] = mfma16(vc[g][dt], pb[0][g], o[dt][0]);
        o[dt][1] = mfma16(vc[g][dt], pb[1][g], o[dt][1]);
      }
#pragma unroll
    for (int kt = 0; kt < 4; ++kt) { kc[kt][0] = kn[kt][0]; kc[kt][1] = kn[kt][1]; }
    if (__all((carry[0] < -104.f) && (carry[1] < -104.f))) break;
  }
  const float inv[2] = {1.f, 1.f};
  write_og4(p, o, inv, b, q0, 512 + h * 64, lane);
}

DEV int wave_sum_dpp(int v) {
  int x = v;
  x += __builtin_amdgcn_update_dpp(0, x, 0x111, 0xf, 0xf, false);
  x += __builtin_amdgcn_update_dpp(0, x, 0x112, 0xf, 0xf, false);
  x += __builtin_amdgcn_update_dpp(0, x, 0x114, 0xf, 0xf, false);
  x += __builtin_amdgcn_update_dpp(0, x, 0x118, 0xf, 0xf, false);
  x += __builtin_amdgcn_update_dpp(0, x, 0x142, 0xa, 0xf, false);
  x += __builtin_amdgcn_update_dpp(0, x, 0x143, 0xc, 0xf, false);
  return __builtin_amdgcn_readlane(x, 63);
}
DEV u16 key16(float s) { u16 u = f2bf(s); return (u & 0x8000u) ? (u16)(~u) : (u16)(u | 0x8000u); }

DEV void dsa_item(const Params& p, int b, int tile16, char* smem, int tid) {
  u16* keys = reinterpret_cast<u16*>(smem);
  u64* maskL = reinterpret_cast<u64*>(smem + 65536);
  const int wave = tid >> 6, lane = tid & 63, lr = lane & 15, quad = lane >> 4;
  const int t0 = tile16 * 16;
  const int nch = ((t0 + 15) >> 6) + 1;
  const size_t tb = (size_t)b * SEQ;
#if DBL == 10
  for (int half2 = 0; half2 < 4; ++half2) {
    const int half = half2 & 1;
#elif DBL == 12
  for (int half2 = 0; half2 < 2; ++half2) {
    const int half = half2;
#else
  for (int half = 0; half < 2; ++half) {
#endif
    const int qh0 = t0 + half * 8;
#if DBL == 12
    for (int rep = 0; rep < 2; ++rep)
#endif
    {
      bf16x8 ax[2], ay[2]; float wx[2][4], wy[2][4];
#pragma unroll
      for (int pr = 0; pr < 2; ++pr) {
        const int q = qh0 + pr * 4 + (lr >> 2);
        ax[pr] = ld8(P_IQ + ((tb + q) * 8 + (lr & 3)) * 32 + quad * 8);
        ay[pr] = ld8(P_IQ + ((tb + q) * 8 + 4 + (lr & 3)) * 32 + quad * 8);
        const int qo = qh0 + pr * 4 + quad;
        const float4 w0 = *reinterpret_cast<const float4*>(P_IW + (tb + qo) * 8);
        const float4 w1 = *reinterpret_cast<const float4*>(P_IW + (tb + qo) * 8 + 4);
        wx[pr][0] = w0.x; wx[pr][1] = w0.y; wx[pr][2] = w0.z; wx[pr][3] = w0.w;
        wy[pr][0] = w1.x; wy[pr][1] = w1.y; wy[pr][2] = w1.z; wy[pr][3] = w1.w;
      }
      for (int tile = wave; tile < ((nch + 1) >> 1) * 8; tile += 4) {
        const int key = tile * 16 + lr;
        const bf16x8 kf = ld8(P_IK + (tb + key) * 32 + quad * 8);
#pragma unroll
        for (int pr = 0; pr < 2; ++pr) {
          f32x4 X = mfma16(ax[pr], kf, f32x4{0.f, 0.f, 0.f, 0.f});
          f32x4 Y = mfma16(ay[pr], kf, f32x4{0.f, 0.f, 0.f, 0.f});
          float sc = 0.f;
#pragma unroll
          for (int j = 0; j < 4; ++j) { sc = fmaf(fmaxf(X[j], 0.f), wx[pr][j], sc); sc = fmaf(fmaxf(Y[j], 0.f), wy[pr][j], sc); }
          const int qo = qh0 + pr * 4 + quad;
          keys[(pr * 4 + quad) * 4096 + (key & ~127) + ((key & 63) << 1) + ((key >> 6) & 1)] = (key <= qo) ? key16(sc) : (u16)0;
        }
      }
    }
    __syncthreads();
    {
      const int qiA = wave * 2, qiB = wave * 2 + 1;
      const unsigned* kpA = reinterpret_cast<const unsigned*>(keys + qiA * 4096) + lane;
      const unsigned* kpB = reinterpret_cast<const unsigned*>(keys + qiB * 4096) + lane;
      const int nrd = (nch + 1) >> 1;
      unsigned TA = 0u, TB = 0u;
      for (int bit = 15; bit >= 0; --bit) {
        const unsigned cA = TA | (1u << bit), cB = TB | (1u << bit);
        int nA = 0, nB = 0;
#pragma unroll 4
        for (int r = 0; r < nrd; ++r) {
          const unsigned ka = kpA[r * 64], kb = kpB[r * 64];
          nA += ((ka & 0xFFFFu) >= cA) + ((ka >> 16) >= cA);
          nB += ((kb & 0xFFFFu) >= cB) + ((kb >> 16) >= cB);
        }
        const int pk = wave_sum_dpp(nA | (nB << 16));
        if ((pk & 0xFFFF) >= 256) TA = cA;
        if ((pk >> 16) >= 256) TB = cB;
      }
#pragma unroll
      for (int qq = 0; qq < 2; ++qq) {
        const unsigned T = qq ? TB : TA;
        const unsigned* kp = qq ? kpB : kpA;
        const int qi = wave * 2 + qq;
        int gl = 0;
#pragma unroll 4
        for (int r = 0; r < nrd; ++r) { const unsigned kv = kp[r * 64]; gl += ((kv & 0xFFFFu) > T) + ((kv >> 16) > T); }
        gl = wave_sum_dpp(gl);
        const int need = (T > 0u) ? (256 - gl) : 0;
        int running = 0;
        const u64 lt_mask = (lane == 0) ? 0ull : (~0ull >> (64 - lane));
        for (int r = 0; r < nrd; ++r) {
          const unsigned kv = kp[r * 64];
#pragma unroll
          for (int hf = 0; hf < 2; ++hf) {
            const unsigned kk = hf ? (kv >> 16) : (kv & 0xFFFFu);
            const bool eq = (T > 0u) && (kk == T);
            const u64 beq = __ballot(eq);
            const int rank = running + __popcll(beq & lt_mask);
            const bool sel = (kk > T) || (eq && rank < need);
            const u64 msk = __ballot(sel);
            running += __popcll(beq);
            if (lane == 0) maskL[(half * 8 + qi) * 64 + r * 2 + hf] = msk;
          }
        }
      }
    }
    __syncthreads();
  }
  {
    char* gbuf = smem + wave * 10752;
    u16* idxL = reinterpret_cast<u16*>(smem + 43008 + wave * 1088);
    unsigned char* flL = reinterpret_cast<unsigned char*>(smem + 47360 + wave * 544);
    const u64 lt_mask2 = (lane == 0) ? 0ull : (~0ull >> (64 - lane));
    const unsigned trbase = (unsigned)(size_t)gbuf + (unsigned)((quad * 4 + ((lane & 15) >> 2)) * 336 + (lane & 3) * 8);
    for (int pp = 0; pp < 2; ++pp) {
      const int pair = wave * 2 + pp;
      int n = 0;
      for (int ch = 0; ch < nch; ++ch) {
        const u64 ma = maskL[(pair * 2) * 64 + ch], mb = maskL[(pair * 2 + 1) * 64 + ch];
        const u64 u = ma | mb;
        if (u == 0ull) continue;
        if ((u >> lane) & 1ull) {
          const int pos = n + __popcll(u & lt_mask2);
          idxL[pos] = (u16)(ch * 64 + lane);
          flL[pos] = (unsigned char)(((ma >> lane) & 1ull) | (((mb >> lane) & 1ull) << 1));
        }
        n += __popcll(u);
      }
      const int npad = (n + 31) & ~31;
      if (lane < npad - n) { idxL[n + lane] = 0; flL[n + lane] = 0; }
      const int ngr = npad >> 5;
      bf16x8 qf[5];
#pragma unroll
      for (int ks = 0; ks < 5; ++ks) qf[ks] = ld8(P_QC + ((tb + t0 + pair * 2 + (lr >> 3)) * 8 + (lr & 7)) * 160 + ks * 32 + quad * 8);
      float m = NEG_INF, l = 0.f;
      f32x4 o[8];
#pragma unroll
      for (int dt = 0; dt < 8; ++dt) o[dt] = f32x4{0.f, 0.f, 0.f, 0.f};
      const int qsel = lr >> 3;
      uint4 gv0, gv1, gv2, gv3, gv4, gv5, gv6, gv7, gv8, gv9;
#define GLOAD(I, G) do { const int pc_ = lane + 64 * (I); const int slot_ = pc_ / 20, piece_ = pc_ - slot_ * 20; \
        const int key_ = idxL[(G) * 32 + slot_]; gv##I = *reinterpret_cast<const uint4*>(P_KVC + (tb + key_) * 160 + piece_ * 8); } while (0)
#define GSTORE(I) do { const int pc_ = lane + 64 * (I); const int slot_ = pc_ / 20, piece_ = pc_ - slot_ * 20; \
        *reinterpret_cast<uint4*>(gbuf + slot_ * 336 + piece_ * 16) = gv##I; } while (0)
      if (ngr > 0) { GLOAD(0, 0); GLOAD(1, 0); GLOAD(2, 0); GLOAD(3, 0); GLOAD(4, 0); GLOAD(5, 0); GLOAD(6, 0); GLOAD(7, 0); GLOAD(8, 0); GLOAD(9, 0); }
      else { gv0 = gv1 = gv2 = gv3 = gv4 = gv5 = gv6 = gv7 = gv8 = gv9 = make_uint4(0u, 0u, 0u, 0u); }
      for (int g = 0; g < ngr; ++g) {
        GSTORE(0); GSTORE(1); GSTORE(2); GSTORE(3); GSTORE(4); GSTORE(5); GSTORE(6); GSTORE(7); GSTORE(8); GSTORE(9);
        if (g + 1 < ngr) { GLOAD(0, g + 1); GLOAD(1, g + 1); GLOAD(2, g + 1); GLOAD(3, g + 1); GLOAD(4, g + 1); GLOAD(5, g + 1); GLOAD(6, g + 1); GLOAD(7, g + 1); GLOAD(8, g + 1); GLOAD(9, g + 1); }
        f32x4 st[2];
#pragma unroll
        for (int kt = 0; kt < 2; ++kt) {
          st[kt] = f32x4{0.f, 0.f, 0.f, 0.f};
#pragma unroll
          for (int ks = 0; ks < 5; ++ks) {
            bf16x8 kf = *reinterpret_cast<const bf16x8*>(gbuf + (kt * 16 + lr) * 336 + ks * 64 + quad * 16);
            st[kt] = mfma16(kf, qf[ks], st[kt]);
          }
        }
        float cm = NEG_INF;
#pragma unroll
        for (int kt = 0; kt < 2; ++kt) {
          const unsigned fw = *reinterpret_cast<const unsigned*>(flL + g * 32 + kt * 16 + quad * 4);
#pragma unroll
          for (int j = 0; j < 4; ++j) {
            const bool v = ((fw >> (8 * j + qsel)) & 1u) != 0u;
            const float sv = v ? st[kt][j] : NEG_INF;
            st[kt][j] = sv; cm = fmaxf(cm, sv);
          }
        }
        cm = xq_max(cm);
        if (!__all(cm <= m + 8.f)) {
          const float mn = fmaxf(m, cm);
          const float msn = (mn == NEG_INF) ? 0.f : mn;
          const float alpha = fexp2(m - msn);
          m = mn;
          l *= alpha;
#pragma unroll
          for (int dt = 0; dt < 8; ++dt) { o[dt][0] *= alpha; o[dt][1] *= alpha; o[dt][2] *= alpha; o[dt][3] *= alpha; }
        }
        const float ms = (m == NEG_INF) ? 0.f : m;
        float ps = 0.f;
#pragma unroll
        for (int kt = 0; kt < 2; ++kt)
#pragma unroll
          for (int j = 0; j < 4; ++j) { const float pv = fexp2(st[kt][j] - ms); st[kt][j] = pv; ps += pv; }
        l += ps;
        const bf16x8 pb = pack8(st[0][0], st[0][1], st[0][2], st[0][3], st[1][0], st[1][1], st[1][2], st[1][3]);
        uint2 ta[8], tc[8];
        asm volatile(
            "s_waitcnt lgkmcnt(0)\n\t"
            "ds_read_b64_tr_b16 %0, %16\n\t"
            "ds_read_b64_tr_b16 %1, %16 offset:32\n\t"
            "ds_read_b64_tr_b16 %2, %16 offset:64\n\t"
            "ds_read_b64_tr_b16 %3, %16 offset:96\n\t"
            "ds_read_b64_tr_b16 %4, %16 offset:128\n\t"
            "ds_read_b64_tr_b16 %5, %16 offset:160\n\t"
            "ds_read_b64_tr_b16 %6, %16 offset:192\n\t"
            "ds_read_b64_tr_b16 %7, %16 offset:224\n\t"
            "ds_read_b64_tr_b16 %8, %16 offset:5376\n\t"
            "ds_read_b64_tr_b16 %9, %16 offset:5408\n\t"
            "ds_read_b64_tr_b16 %10, %16 offset:5440\n\t"
            "ds_read_b64_tr_b16 %11, %16 offset:5472\n\t"
            "ds_read_b64_tr_b16 %12, %16 offset:5504\n\t"
            "ds_read_b64_tr_b16 %13, %16 offset:5536\n\t"
            "ds_read_b64_tr_b16 %14, %16 offset:5568\n\t"
            "ds_read_b64_tr_b16 %15, %16 offset:5600\n\t"
            "s_waitcnt lgkmcnt(0)"
            : "=&v"(ta[0]), "=&v"(ta[1]), "=&v"(ta[2]), "=&v"(ta[3]), "=&v"(ta[4]), "=&v"(ta[5]), "=&v"(ta[6]), "=&v"(ta[7]),
              "=&v"(tc[0]), "=&v"(tc[1]), "=&v"(tc[2]), "=&v"(tc[3]), "=&v"(tc[4]), "=&v"(tc[5]), "=&v"(tc[6]), "=&v"(tc[7])
            : "v"(trbase)
            : "memory");
#pragma unroll
        for (int dt = 0; dt < 8; ++dt) {
          union { bf16x8 v; unsigned u[4]; } vf;
          vf.u[0] = ta[dt].x; vf.u[1] = ta[dt].y; vf.u[2] = tc[dt].x; vf.u[3] = tc[dt].y;
          o[dt] = mfma16(vf.v, pb, o[dt]);
        }
      }
      const float inv = 1.f / quad_sum(l);
      u16* op = P_OLAT + ((tb + t0 + pair * 2 + qsel) * 8 + (lr & 7)) * 128 + quad * 4;
#pragma unroll
      for (int dt = 0; dt < 8; ++dt) st8b(op + dt * 16, o[dt][0] * inv, o[dt][1] * inv, o[dt][2] * inv, o[dt][3] * inv);
    }
  }
  __threadfence_block();
  __syncthreads();
#pragma unroll
  for (int c = 0; c < 2; ++c) {
    const int h = wave * 2 + c;
    f32x4 res[4];
#pragma unroll
    for (int dvt = 0; dvt < 4; ++dvt) res[dvt] = f32x4{0.f, 0.f, 0.f, 0.f};
#pragma unroll
    for (int g = 0; g < 4; ++g) {
      const bf16x8 pbv = ld8(P_OLAT + ((tb + t0 + lr) * 8 + h) * 128 + g * 32 + quad * 8);
#pragma unroll
      for (int dvt = 0; dvt < 4; ++dvt) {
        const bf16x8 wf = ld8(P_WUVp + ((size_t)(h * 64 + dvt * 16 + lr)) * 128 + g * 32 + quad * 8);
        res[dvt] = mfma16(wf, pbv, res[dvt]);
      }
    }
    const size_t base = (tb + t0 + lr) * 1024 + h * 64 + quad * 4;
#pragma unroll
    for (int dvt = 0; dvt < 4; ++dvt) {
      uint2 sg = *reinterpret_cast<const uint2*>(P_SG + base + dvt * 16);
      float g0 = bf2f((u16)(sg.x & 0xFFFF)), g1 = bf2f((u16)(sg.x >> 16)), g2 = bf2f((u16)(sg.y & 0xFFFF)), g3 = bf2f((u16)(sg.y >> 16));
      st8b(P_OG + base + dvt * 16, res[dvt][0] * g0, res[dvt][1] * g1, res[dvt][2] * g2, res[dvt][3] * g3);
    }
  }
}

DEV void phase_attn(const Params& p, int layer, char* smem, int tid_in, int ctr_idx, int it_lo, int it_hi) {
  int* s_item = reinterpret_cast<int*>(smem + 73728);
  for (;;) {
    const int tid = opq(tid_in);
    const int wave = tid >> 6, lane = tid & 63;
    if (tid == 0) *s_item = atomicAdd(P_ctr + ctr_idx, 1);
    __syncthreads();
    const int it = *s_item + it_lo;
    __syncthreads();
    if (it >= it_hi) break;
    if (layer == 0) {
      if (it < 1024) { const int qt = 31 - (it >> 5), bh = it & 31; moba_item(p, bh >> 3, bh & 7, qt, wave, lane, smem); }
      else { const int i = it - 1024; const int t32 = i >> 3, bk = i & 7; swa_item(p, bk >> 1, bk & 1, t32, wave, lane, smem); }
    } else {
      if (it < 1024) { const int tile16 = 255 - (it >> 2), b = it & 3; dsa_item(p, b, tile16, smem, tid); }
      else { const int i = it - 1024; const int qt = i >> 5, bh = i & 31; sb_item(p, bh >> 3, bh & 7, qt, wave, lane); }
    }
  }
}

__global__ void __launch_bounds__(256, 2) fwd_megakernel(Params p) {
  __shared__ __attribute__((aligned(16))) char smem[73728 + 64];
  cg::grid_group grid = cg::this_grid();
  __shared__ uint4 xb_words;
  if (threadIdx.x == 0) xb_words = make_uint4(0u, 0u, 0u, 0u);
  __syncthreads();
  XcdBarrier xb = xcd_barrier_post(P_bar, (volatile LAS unsigned*)&xb_words);
  if (p.out == nullptr) grid.sync();
#define OPQ_TID() ({ int t_; asm volatile("v_mov_b32 %0, %1" : "=v"(t_) : "v"((int)threadIdx.x)); t_; })
#define GSYNC() xcd_barrier(xb)
#define VID() ((int)((volatile LAS unsigned*)&xb_words)[3])
  phase0(p, smem, OPQ_TID());
  GSYNC();
  phase_prep(p, 0, OPQ_TID());
  GSYNC();
  phase_inproj(p, 0, smem, OPQ_TID(), VID());
#if DBL == 1
  GSYNC(); phase_inproj(p, 0, smem, OPQ_TID(), VID());
#endif
  GSYNC();
  phase_attn(p, 0, smem, OPQ_TID(), 0, 0, 2048);
#if DBL == 2
  GSYNC(); phase_attn(p, 0, smem, OPQ_TID(), 2, 0, 1024);
#elif DBL == 7
  GSYNC(); phase_attn(p, 0, smem, OPQ_TID(), 2, 1024, 2048);
#endif
  GSYNC();
  phase_outproj(p, 0, smem, OPQ_TID(), VID());
#if DBL == 3
  GSYNC(); phase_outproj(p, 0, smem, OPQ_TID(), VID());
#endif
  GSYNC();
  phase_prep(p, 1, OPQ_TID());
  GSYNC();
  phase_inproj(p, 1, smem, OPQ_TID(), VID());
#if DBL == 4
  GSYNC(); phase_inproj(p, 1, smem, OPQ_TID(), VID());
#endif
  GSYNC();
  phase_attn(p, 1, smem, OPQ_TID(), 1, 0, 2048);
#if DBL == 5
  GSYNC(); phase_attn(p, 1, smem, OPQ_TID(), 3, 0, 1024);
#elif DBL == 6
  GSYNC(); phase_attn(p, 1, smem, OPQ_TID(), 3, 1024, 2048);
#endif
  GSYNC();
  phase_outproj(p, 1, smem, OPQ_TID(), VID());
  GSYNC();
  phase_final_ln(p, OPQ_TID());
}

extern "C" void kernel_launch(void* const* d_in, const int* in_sizes, int n_in, void* d_out, int out_size,
                              void* d_ws, size_t ws_size, hipStream_t stream) {
  static int grid_blocks = 0;
  if (!grid_blocks) {
    int dev = 0, cus = 0, per_cu = 0;
    hipGetDevice(&dev);
    hipDeviceGetAttribute(&cus, hipDeviceAttributeMultiprocessorCount, dev);
    hipOccupancyMaxActiveBlocksPerMultiprocessor(&per_cu, fwd_megakernel, 256, 0);
    if (per_cu < 1) per_cu = 1;
    if (per_cu > 2) per_cu = 2;
    grid_blocks = cus * per_cu;
  }
  Params p{};
  p.x = (const float*)d_in[0]; p.c = (const float*)d_in[1]; p.w_ada = (const float*)d_in[2]; p.b_ada = (const float*)d_in[3];
  p.w_in_even = (const float*)d_in[4]; p.sinks = (const float*)d_in[5]; p.w_in_odd = (const float*)d_in[6]; p.kvg = (const float*)d_in[7];
  p.w_uk = (const float*)d_in[8]; p.w_uv = (const float*)d_in[9]; p.w_out = (const float*)d_in[10]; p.ln_g = (const float*)d_in[11]; p.ln_b = (const float*)d_in[12];
  p.out = (float*)d_out;
  p.ws = (char*)d_ws;
  if (WS_NEEDED > ws_size) { fprintf(stderr, "workspace too small: need %zu have %zu\n", (size_t)WS_NEEDED, ws_size); return; }
  hipMemsetAsync(p.ws + 24871168ull, 0, (size_t)XCD_BAR_WORDS * 4, stream);
  void* args[] = {&p};
  hipError_t e = hipLaunchCooperativeKernel((void*)fwd_megakernel, dim3(grid_blocks), dim3(256), args, 0, stream);
  if (e != hipSuccess) fprintf(stderr, "cooperative launch failed: %s (grid %d)\n", hipGetErrorString(e), grid_blocks);
}
```
